# Optimizing an MI355X kernel written in HIP

```python
import jax
import jax.numpy as jnp
from jax import lax
import numpy as np

D_MODEL = 2048
BATCH = 4
SEQ = 4096
DEPTH = 1

CHUNK = 64
SUB_CHUNK = 16
CONV_WIDTH = 4
GDN_HEAD_DIM = 128
GDN_HEADS = D_MODEL // (2 * GDN_HEAD_DIM)
GDN_WIDTH = GDN_HEADS * GDN_HEAD_DIM
HGRN_HEAD_DIM = 128
HGRN_VALUE_DIM = 128
HGRN_HEADS = D_MODEL // (2 * HGRN_VALUE_DIM)
HGRN_WIDTH = HGRN_HEADS * HGRN_HEAD_DIM
HGRN_V_WIDTH = HGRN_HEADS * HGRN_VALUE_DIM
D_MIX = GDN_WIDTH + HGRN_V_WIDTH
IN_PROJ_WIDTH = 4 * GDN_WIDTH + 2 * GDN_HEADS + 2 * HGRN_WIDTH + 2 * HGRN_V_WIDTH
D_FF = 4 * D_MODEL
NORM_EPS = 1e-6
L2_EPS = 1e-6

kernel_name = 'hybrid_gdn_hgrn2_block'


def rms_norm(x, w):
    xf = x.astype(jnp.float32)
    y = xf * lax.rsqrt(jnp.mean(xf * xf, axis=-1, keepdims=True) + NORM_EPS)
    return (y * w.astype(jnp.float32)).astype(x.dtype)


def head_rms_norm(o, w):
    return o * lax.rsqrt(jnp.mean(o * o, axis=-1, keepdims=True) + NORM_EPS) * w.astype(jnp.float32)


def l2_normalize(t):
    return t * lax.rsqrt(jnp.sum(t * t, axis=-1, keepdims=True) + L2_EPS)


def to_heads(t, n_heads):
    b, s, _ = t.shape
    return t.reshape(b, s, n_heads, -1).transpose(0, 2, 1, 3).astype(jnp.float32)


def from_heads(t):
    b, h, s, d = t.shape
    return t.transpose(0, 2, 1, 3).reshape(b, s, h * d)


def causal_depthwise_conv(t, w):
    return lax.conv_general_dilated(
        t, w[:, None, :].astype(t.dtype), window_strides=(1,),
        padding=[(w.shape[0] - 1, 0)], dimension_numbers=('NWC', 'WIO', 'NWC'),
        feature_group_count=t.shape[-1])


def gated_delta_rule_chunked(q, k, v, beta, g):
    b_, h_, t_, dk = q.shape
    dv = v.shape[-1]
    n_chunks = t_ // CHUNK
    q, k, v, beta, g = (t.reshape(b_, h_, n_chunks, CHUNK, *t.shape[3:]) for t in (q, k, v, beta, g))
    G = jnp.cumsum(g, axis=-1)
    pos = jnp.arange(CHUNK)
    incl = pos[:, None] >= pos[None, :]
    strict = pos[:, None] > pos[None, :]
    decay = jnp.exp(jnp.where(incl, G[..., :, None] - G[..., None, :], -jnp.inf))
    kk = jnp.einsum('bhncd,bhnsd->bhncs', k, k)
    unit_lower = jnp.where(strict, beta[..., :, None] * kk * decay, 0.0) + jnp.eye(CHUNK, dtype=jnp.float32)
    rhs = beta[..., None] * jnp.concatenate([v, jnp.exp(G)[..., None] * k], axis=-1)
    sol = lax.linalg.triangular_solve(unit_lower, rhs, left_side=True, lower=True, unit_diagonal=True)
    u_v, w = sol[..., :dv], sol[..., dv:]
    attn = jnp.einsum('bhncd,bhnsd->bhncs', q, k) * decay
    q_g = q * jnp.exp(G)[..., None]
    g_last = G[..., -1:]
    k_end = k * jnp.exp(g_last - G)[..., None]
    state_decay = jnp.exp(G[..., -1])

    def step(S, xs):
        u_v_c, w_c, q_c, attn_c, k_c, sd_c = xs
        u = u_v_c - jnp.einsum('bhcd,bhde->bhce', w_c, S)
        o = jnp.einsum('bhcd,bhde->bhce', q_c, S) + jnp.einsum('bhcs,bhse->bhce', attn_c, u)
        S = S * sd_c[..., None, None] + jnp.einsum('bhcd,bhce->bhde', k_c, u)
        return S, o

    xs = tuple(jnp.moveaxis(t, 2, 0) for t in (u_v, w, q_g, attn, k_end, state_decay))
    s0 = jnp.zeros((b_, h_, dk, dv), jnp.float32)
    _, o = lax.scan(step, s0, xs)
    return jnp.moveaxis(o, 0, 2).reshape(b_, h_, t_, dv)


def hgrn2_chunked(q, k, v, log_f):
    b_, h_, t_, dk = q.shape
    dv = v.shape[-1]
    n_chunks = t_ // CHUNK
    n_sub = CHUNK // SUB_CHUNK
    b_cum = jnp.cumsum(log_f.reshape(b_, h_, n_chunks, CHUNK, dk), axis=3)

    def blocks(t):
        return jnp.moveaxis(t.reshape(b_, h_, n_chunks, n_sub, SUB_CHUNK, t.shape[-1]), 2, 0)

    sub = jnp.arange(SUB_CHUNK)
    diag_mask = (sub[:, None] >= sub[None, :])[:, :, None]
    blk = jnp.arange(n_sub)
    off_mask = (blk[:, None] > blk[None, :])[:, :, None]

    def step(S, xs):
        qc, kc, vc, bc = xs
        b_end = bc[..., -1, :]
        b_start = jnp.concatenate([jnp.zeros_like(b_end[..., :1, :]), b_end[..., :-1, :]], axis=-2)
        o_inter = jnp.einsum('bhsid,bhde->bhsie', qc * jnp.exp(bc), S)
        d_diag = jnp.exp(jnp.where(diag_mask, bc[..., :, None, :] - bc[..., None, :, :], -jnp.inf))
        a_diag = jnp.einsum('bhsid,bhsijd,bhsjd->bhsij', qc, d_diag, kc)
        q_rel = qc * jnp.exp(bc - b_start[..., None, :])
        k_rel = kc * jnp.exp(b_end[..., None, :] - bc)
        d_off = jnp.exp(jnp.where(off_mask, b_start[..., :, None, :] - b_end[..., None, :, :], -jnp.inf))
        a_off = jnp.einsum('bhxid,bhxyd,bhyjd->bhxyij', q_rel, d_off, k_rel)
        o = (o_inter + jnp.einsum('bhsij,bhsje->bhsie', a_diag, vc)
             + jnp.einsum('bhxyij,bhyje->bhxie', a_off, vc))
        b_last = b_end[..., -1, :]
        k_state = kc * jnp.exp(b_last[:, :, None, None, :] - bc)
        S = S * jnp.exp(b_last)[..., None] + jnp.einsum('bhsjd,bhsje->bhde', k_state, vc)
        return S, o

    xs = (blocks(q), blocks(k), blocks(v), blocks(b_cum))
    s0 = jnp.zeros((b_, h_, dk, dv), jnp.float32)
    _, o = lax.scan(step, s0, xs)
    return jnp.moveaxis(o, 0, 2).reshape(b_, h_, t_, dv)


def gated_deltanet_group(qkv, z, a, b, conv_w, a_log, dt_bias, norm_w):
    qkv = jax.nn.silu(causal_depthwise_conv(qkv, conv_w))
    q, k, v = jnp.split(qkv, 3, axis=-1)
    q = l2_normalize(to_heads(q, GDN_HEADS)) * (GDN_HEAD_DIM ** -0.5)
    k = l2_normalize(to_heads(k, GDN_HEADS))
    v = to_heads(v, GDN_HEADS)
    beta = jax.nn.sigmoid(b.astype(jnp.float32)).transpose(0, 2, 1)
    g = (-jnp.exp(a_log.astype(jnp.float32))
         * jax.nn.softplus(a.astype(jnp.float32) + dt_bias.astype(jnp.float32))).transpose(0, 2, 1)
    o = gated_delta_rule_chunked(q, k, v, beta, g)
    o = head_rms_norm(o, norm_w) * jax.nn.silu(to_heads(z, GDN_HEADS))
    return from_heads(o)


def hgrn2_group(q, f, i, g, lower_bound, norm_w):
    lb = lower_bound.reshape(HGRN_HEADS, 1, HGRN_HEAD_DIM)
    f_logit = to_heads(f, HGRN_HEADS)
    forget = lb + (1.0 - lb) * jax.nn.sigmoid(f_logit)
    key = (1.0 - lb) * jax.nn.sigmoid(-f_logit)
    o = hgrn2_chunked(jax.nn.silu(to_heads(q, HGRN_HEADS)), key, to_heads(i, HGRN_HEADS), jnp.log(forget))
    o = head_rms_norm(o, norm_w) * jax.nn.silu(to_heads(g, HGRN_HEADS))
    return from_heads(o)


def hybrid_token_mixer(n, w_in, conv_w, a_log, dt_bias, gdn_norm_w, lower_bound, hgrn_norm_w, w_out):
    proj = n @ w_in
    o1 = 3 * GDN_WIDTH
    o2 = o1 + GDN_WIDTH
    o3 = o2 + GDN_HEADS
    o4 = o3 + GDN_HEADS
    o5 = o4 + HGRN_WIDTH
    o6 = o5 + HGRN_WIDTH
    o7 = o6 + HGRN_V_WIDTH
    qkv_a, z_a, a_a, b_a, q_b, f_b, i_b, g_b = jnp.split(proj, [o1, o2, o3, o4, o5, o6, o7], axis=-1)
    y_a = gated_deltanet_group(qkv_a, z_a, a_a, b_a, conv_w, a_log, dt_bias, gdn_norm_w)
    y_b = hgrn2_group(q_b, f_b, i_b, g_b, lower_bound, hgrn_norm_w)
    y = jnp.concatenate([y_a, y_b], axis=-1).astype(n.dtype)
    return y @ w_out


def squared_relu_mlp(n, w1, w2):
    return jnp.square(jax.nn.relu(n @ w1)) @ w2


def setup_inputs(seed: int = 0) -> dict:
    key = jax.random.key(seed)
    ks = jax.random.split(key, 16)
    f32 = jnp.float32
    x = jax.random.normal(ks[0], (BATCH, SEQ, D_MODEL), f32)
    w_in = jax.random.normal(ks[1], (DEPTH, D_MODEL, IN_PROJ_WIDTH), f32) * D_MODEL ** -0.5
    conv_w = jax.random.normal(ks[2], (DEPTH, CONV_WIDTH, 3 * GDN_WIDTH), f32) * CONV_WIDTH ** -0.5
    gdn_a_log = jnp.log(jax.random.uniform(ks[3], (DEPTH, GDN_HEADS), f32, 1.0, 16.0))
    dt = jnp.exp(jax.random.uniform(ks[4], (DEPTH, GDN_HEADS), f32, np.log(1e-3), np.log(1e-1)))
    gdn_dt_bias = dt + jnp.log(-jnp.expm1(-dt))
    gdn_norm_w = 1.0 + 0.02 * jax.random.normal(ks[5], (DEPTH, GDN_HEAD_DIM), f32)
    hgrn_lb_logits = 0.1 * jax.random.normal(ks[6], (DEPTH + 1, HGRN_WIDTH), f32)
    hgrn_norm_w = 1.0 + 0.02 * jax.random.normal(ks[7], (DEPTH, HGRN_VALUE_DIM), f32)
    w_out = jax.random.normal(ks[8], (DEPTH, D_MIX, D_MODEL), f32) * D_MIX ** -0.5
    norm_mix_w = 1.0 + 0.02 * jax.random.normal(ks[9], (DEPTH, D_MODEL), f32)
    norm_ffn_w = 1.0 + 0.02 * jax.random.normal(ks[10], (DEPTH, D_MODEL), f32)
    w_ff1 = jax.random.normal(ks[11], (DEPTH, D_MODEL, D_FF), f32) * D_MODEL ** -0.5
    w_ff2 = jax.random.normal(ks[12], (DEPTH, D_FF, D_MODEL), f32) * D_FF ** -0.5
    norm_final_w = 1.0 + 0.02 * jax.random.normal(ks[13], (D_MODEL,), f32)
    return {'x': x, 'w_in': w_in, 'conv_w': conv_w, 'gdn_a_log': gdn_a_log,
            'gdn_dt_bias': gdn_dt_bias, 'gdn_norm_w': gdn_norm_w, 'hgrn_lb_logits': hgrn_lb_logits,
            'hgrn_norm_w': hgrn_norm_w, 'w_out': w_out, 'norm_mix_w': norm_mix_w,
            'norm_ffn_w': norm_ffn_w, 'w_ff1': w_ff1, 'w_ff2': w_ff2, 'norm_final_w': norm_final_w}


def reference(x, w_in, conv_w, gdn_a_log, gdn_dt_bias, gdn_norm_w, hgrn_lb_logits, hgrn_norm_w,
              w_out, norm_mix_w, norm_ffn_w, w_ff1, w_ff2, norm_final_w):
    lower_bounds = jnp.cumsum(jax.nn.softmax(hgrn_lb_logits.astype(jnp.float32), axis=0), axis=0)
    h = x
    for layer in range(DEPTH):
        n = rms_norm(h, norm_mix_w[layer])
        h = h + hybrid_token_mixer(n, w_in[layer], conv_w[layer], gdn_a_log[layer], gdn_dt_bias[layer],
                                   gdn_norm_w[layer], lower_bounds[layer], hgrn_norm_w[layer], w_out[layer])
        n = rms_norm(h, norm_ffn_w[layer])
        h = h + squared_relu_mlp(n, w_ff1[layer], w_ff2[layer])
    return rms_norm(h, norm_final_w)
```

```cpp
#include <hip/hip_runtime.h>
#include <cstdio>
#include <cstdint>
namespace pg8 {
#define PG8_LAS __attribute__((address_space(3)))
typedef unsigned short bf16_t;
typedef short bf16x8 __attribute__((ext_vector_type(8)));
typedef float f32x4 __attribute__((ext_vector_type(4)));
typedef unsigned u32x4 __attribute__((ext_vector_type(4)));
constexpr int BM = 256, BK = 64, HALF = 128, HTB = HALF * BK * 2  , STAGE_BYTES = 8 * HTB, NXCD = 8, WGM = 8;

__host__ __device__ __forceinline__ int lds_byte(int r, int c) { const int st = (r >> 4) * 2 + (c >> 5), rr = r & 15, cc = c & 31, ob = rr * 64 + cc * 2; return st * 1024 + (ob ^ (((ob >> 9) & 1) << 5)); }
__host__ __device__ __forceinline__ void stage_rc(int b, int& R, int& C) { const int st = b / 1024, sb = b % 1024, swz = sb ^ (((sb >> 9) & 1) << 5); R = (st >> 1) * 16 + swz / 64; C = (st & 1) * 32 + (swz % 64) / 2; }
__host__ __device__ __forceinline__ int perm32(int rho) { const int n = rho >> 4, i = rho & 15; return 8 * (i >> 2) + 4 * n + (i & 3); }

struct Unit { int pm, pn; };
struct Gemm { const bf16_t* A; const bf16_t* Bt; int M, N, K; };

struct StaticOrder {
    int nM, nN, nwg, G, c;
    __host__ __device__ void init(int M, int N, int G_, int c_) { nM = M / BM; nN = N / BM; nwg = nM * nN; G = G_; c = c_; }
    __host__ __device__ bool next(int i, Unit& u) const {
        const long L = (long)i * G + c; if (L >= nwg) return false;
        int wgid = (int)L; { const int q = nwg / NXCD, r = nwg % NXCD, xcd = wgid % NXCD, off = wgid / NXCD; wgid = (xcd < r ? xcd * (q + 1) : r * (q + 1) + (xcd - r) * q) + off; }
        const int nig = WGM * nN, gid = wgid / nig, fm = gid * WGM, gsz = (nM - fm) < WGM ? (nM - fm) : WGM;
        u.pm = fm + ((wgid % nig) % gsz); u.pn = (wgid % nig) / gsz; return true;
    }
    __device__ __forceinline__ void a_ready(const Unit&) const {}
    __device__ __forceinline__ void done(const Unit&) const {}
};

__device__ __forceinline__ unsigned cvt_pk_bf16(float lo, float hi) { unsigned r; asm volatile("v_cvt_pk_bf16_f32 %0, %1, %2" : "=v"(r) : "v"(lo), "v"(hi)); return r; }
typedef float f32x2 __attribute__((ext_vector_type(2)));
struct EpiBf16Split {
    static constexpr bool PERM = true, AFTER_DRAIN = false;
    bf16_t* O; int ldc; int split_cols; size_t split_stride;
    __device__ __forceinline__ void operator()(const f32x4 (&acc)[2][2][4][2], const Unit& u, int wr, int wc, int fr, int fq) const {
        const int row0 = u.pm * BM + wr * 64 + fr; int colt = u.pn * BM; bf16_t* base = O;
        { const int t = colt / split_cols; base += (size_t)t * split_stride; colt -= t * split_cols; }
        const int col0 = colt + wc * 32 + 8 * fq;
#pragma unroll
        for (int ai = 0; ai < 2; ++ai)
#pragma unroll
            for (int m = 0; m < 4; ++m) { bf16_t* rowp = base + (size_t)(row0 + ai * HALF + m * 16) * ldc + col0;
#pragma unroll
                for (int bj = 0; bj < 2; ++bj) { const f32x4 v0 = acc[ai][bj][m][0], v1 = acc[ai][bj][m][1];
                    u32x4 w; w.x = cvt_pk_bf16(v0[0], v0[1]); w.y = cvt_pk_bf16(v0[2], v0[3]); w.z = cvt_pk_bf16(v1[0], v1[1]); w.w = cvt_pk_bf16(v1[2], v1[3]);
                    *(u32x4*)(rowp + bj * HALF) = w; } }
    }
};
template <bool WRITE_BF16> struct EpiResid {
    static constexpr bool PERM = true, AFTER_DRAIN = false;
    const float* base; float* out; bf16_t* hb; float* ss; int ldc;
    __device__ __forceinline__ void operator()(const f32x4 (&acc)[2][2][4][2], const Unit& u, int wr, int wc, int fr, int fq) const {
        const int row0 = u.pm * BM + wr * 64 + fr, col0 = u.pn * BM + wc * 32 + 8 * fq;
#pragma unroll
        for (int ai = 0; ai < 2; ++ai)
#pragma unroll
            for (int m = 0; m < 4; ++m) { const int row = row0 + ai * HALF + m * 16; const size_t off = (size_t)row * ldc + col0; float sq = 0.f;
#pragma unroll
                for (int bj = 0; bj < 2; ++bj) {
                    const f32x4 b0 = *(const f32x4*)(base + off + bj * HALF), b1 = *(const f32x4*)(base + off + bj * HALF + 4);
                    const f32x4 v0 = acc[ai][bj][m][0] + b0, v1 = acc[ai][bj][m][1] + b1;
                    sq += (v0[0] * v0[0] + v0[1] * v0[1]) + (v0[2] * v0[2] + v0[3] * v0[3]) + (v1[0] * v1[0] + v1[1] * v1[1]) + (v1[2] * v1[2] + v1[3] * v1[3]);
                    *(f32x4*)(out + off + bj * HALF) = v0; *(f32x4*)(out + off + bj * HALF + 4) = v1;
                    if (WRITE_BF16) { u32x4 w; w.x = cvt_pk_bf16(v0[0], v0[1]); w.y = cvt_pk_bf16(v0[2], v0[3]); w.z = cvt_pk_bf16(v1[0], v1[1]); w.w = cvt_pk_bf16(v1[2], v1[3]);
                        *(u32x4*)(hb + off + bj * HALF) = w; } }
                sq += __shfl_xor(sq, 16); sq += __shfl_xor(sq, 32);
                if (fq == 0) ss[(size_t)row * 32 + u.pn * 4 + wc] = sq;
                if (m & 1) asm volatile("" ::: "memory"); }
    }
};
struct EpiAct {
    static constexpr bool PERM = true, AFTER_DRAIN = false;
    bf16_t* O; int ldc; const float* ss; float inv_n, eps;
    __device__ __forceinline__ void operator()(const f32x4 (&acc)[2][2][4][2], const Unit& u, int wr, int wc, int fr, int fq) const {
        const int row0 = u.pm * BM + wr * 64 + fr, col0 = u.pn * BM + wc * 32 + 8 * fq;
#pragma unroll
        for (int ai = 0; ai < 2; ++ai)
#pragma unroll
            for (int m = 0; m < 4; ++m) { const int row = row0 + ai * HALF + m * 16;
                const f32x4 p0 = *(const f32x4*)(ss + (size_t)row * 32 + 8 * fq), p1 = *(const f32x4*)(ss + (size_t)row * 32 + 8 * fq + 4);
                float s = ((p0[0] + p0[1]) + (p0[2] + p0[3])) + ((p1[0] + p1[1]) + (p1[2] + p1[3]));
                s += __shfl_xor(s, 16); s += __shfl_xor(s, 32);
                const float r2 = 1.0f / (s * inv_n + eps);
                bf16_t* rowp = O + (size_t)row * ldc + col0;
#pragma unroll
                for (int bj = 0; bj < 2; ++bj) { f32x4 v0 = acc[ai][bj][m][0], v1 = acc[ai][bj][m][1];
#pragma unroll
                    for (int e = 0; e < 4; ++e) { const float a = fmaxf(v0[e], 0.f), b = fmaxf(v1[e], 0.f); v0[e] = a * a * r2; v1[e] = b * b * r2; }
                    u32x4 w; w.x = cvt_pk_bf16(v0[0], v0[1]); w.y = cvt_pk_bf16(v0[2], v0[3]); w.z = cvt_pk_bf16(v1[0], v1[1]); w.w = cvt_pk_bf16(v1[2], v1[3]);
                    *(u32x4*)(rowp + bj * HALF) = w; } }
    }
};

template <class Epi, class Sched, bool ALIGN_EPI = false, bool SP2 = false>
__device__ __forceinline__ void gemm_phase(PG8_LAS unsigned char* lds, const Gemm g, const Sched& S, const Epi& E) {
    const int tid = threadIdx.x, wid = __builtin_amdgcn_readfirstlane(tid >> 6), lane = tid & 63, wr = wid >> 2, wc = wid & 3, fr = lane & 15, fq = lane >> 4;
    const int K = g.K, nt = K / BK;
    unsigned voffA[2], voffB[2];
#pragma unroll
    for (int i = 0; i < 2; ++i) { int R, C; stage_rc(tid * 16 + i * 8192, R, C); const int Rb = Epi::PERM ? ((R & ~31) + perm32(R & 31)) : R;
        voffA[i] = (unsigned)(R * K + C) * 2u; voffB[i] = (unsigned)(Rb * K + C) * 2u; }
    const size_t kstep = (size_t)(BK * 2);
    const size_t hstep = (size_t)HALF * K * 2;
    const size_t tstep = 2 * hstep;
    const unsigned ldsw = (unsigned)wid * 1024u;
    const int aoff = lds_byte(wr * 64 + fr, fq * 8), boff = lds_byte(wc * 32 + fr, fq * 8);
#define PG8_SA(b, h) (((b) * 2 + (h)) * HTB)
#define PG8_SB(b, h) ((4 + (b) * 2 + (h)) * HTB)
#define PG8_STAGE(bufoff, gbase, voff) do { _Pragma("unroll") for (int _i = 0; _i < 2; ++_i) \
        __builtin_amdgcn_global_load_lds((const unsigned*)((const char*)(gbase) + (voff)[_i]), (PG8_LAS unsigned*)(lds + (bufoff) + ldsw + _i * 8192), 16, 0, 0); } while (0)
#define PG8_LDA(dst, b, h) do { _Pragma("unroll") for (int m = 0; m < 4; ++m) _Pragma("unroll") for (int k = 0; k < 2; ++k) dst[m][k] = *(const PG8_LAS bf16x8*)(lds + PG8_SA(b, h) + aoff + m * 2048 + k * 1024); } while (0)
#define PG8_LDB(dst, b, h) do { _Pragma("unroll") for (int n = 0; n < 2; ++n) _Pragma("unroll") for (int k = 0; k < 2; ++k) dst[n][k] = *(const PG8_LAS bf16x8*)(lds + PG8_SB(b, h) + boff + n * 2048 + k * 1024); } while (0)
#define PG8_MMA(ai, bj, At, Bt) do { __builtin_amdgcn_s_setprio(1); _Pragma("unroll") for (int m = 0; m < 4; ++m) _Pragma("unroll") for (int n = 0; n < 2; ++n) _Pragma("unroll") for (int k = 0; k < 2; ++k) \
        acc[ai][bj][m][n] = __builtin_amdgcn_mfma_f32_16x16x32_bf16(Bt[n][k], At[m][k], acc[ai][bj][m][n], 0, 0, 0); __builtin_amdgcn_s_setprio(0); } while (0)
#define PG8_WAIT_V(n) asm volatile("s_waitcnt vmcnt(" #n ")" ::: "memory")
#define PG8_WAIT_L(n) asm volatile("s_waitcnt lgkmcnt(" #n ")" ::: "memory")
#define PG8_BAR __builtin_amdgcn_s_barrier()
#define PG8_SCHED __builtin_amdgcn_sched_barrier(0)
    Unit cur, nxt; int ui = 0;
    if (!S.next(0, cur)) return;
    f32x4 acc[2][2][4][2];
#pragma unroll
    for (int a = 0; a < 2; ++a)
#pragma unroll
        for (int b = 0; b < 2; ++b)
#pragma unroll
            for (int m = 0; m < 4; ++m)
#pragma unroll
                for (int n = 0; n < 2; ++n) acc[a][b][m][n] = (f32x4){0.f, 0.f, 0.f, 0.f};
    bf16x8 At[4][2], B0[2][2], B1[2][2];
    const char* cA = (const char*)g.A + (size_t)cur.pm * tstep; const char* cB = (const char*)g.Bt + (size_t)cur.pn * tstep;
    S.a_ready(cur);
    if constexpr (SP2) {
        PG8_STAGE(PG8_SB(0, 0), cB, voffB); PG8_STAGE(PG8_SB(0, 1), cB + hstep, voffB); PG8_STAGE(PG8_SA(0, 0), cA, voffA); PG8_STAGE(PG8_SA(0, 1), cA + hstep, voffA);
        if (wr == 1) PG8_BAR;
        PG8_WAIT_V(2); PG8_BAR;
        PG8_STAGE(PG8_SB(1, 0), cB + kstep, voffB); PG8_STAGE(PG8_SA(1, 0), cA + kstep, voffA); PG8_STAGE(PG8_SB(1, 1), cB + hstep + kstep, voffB);
        PG8_WAIT_V(6); PG8_BAR;
    } else {
        PG8_STAGE(PG8_SB(0, 0), cB, voffB); PG8_STAGE(PG8_SA(0, 0), cA, voffA); PG8_STAGE(PG8_SB(0, 1), cB + hstep, voffB); PG8_STAGE(PG8_SA(0, 1), cA + hstep, voffA);
        if (wr == 1) PG8_BAR;
        PG8_WAIT_V(4); PG8_BAR;
        PG8_STAGE(PG8_SB(1, 0), cB + kstep, voffB); PG8_STAGE(PG8_SA(1, 0), cA + kstep, voffA); PG8_STAGE(PG8_SB(1, 1), cB + hstep + kstep, voffB);
        PG8_WAIT_V(6); PG8_BAR;
    }
    for (;;) {
        const bool has_next = S.next(ui + 1, nxt);
        const char* nA = has_next ? (const char*)g.A + (size_t)nxt.pm * tstep : cA; const char* nB = has_next ? (const char*)g.Bt + (size_t)nxt.pn * tstep : cB;
        for (int t = 0; t < nt; t += 2) {
            const bool last = (t == nt - 2);
            const char* a1 = cA + (size_t)(t + 1) * kstep;
            const char* a2 = last ? nA : cA + (size_t)(t + 2) * kstep; const char* b2 = last ? nB : cB + (size_t)(t + 2) * kstep;
            const char* a3 = a2 + kstep; const char* b3 = b2 + kstep;
            if (last && has_next) S.a_ready(nxt);
            if constexpr (SP2) {
            PG8_LDB(B0, 0, 0); PG8_LDB(B1, 0, 1); PG8_SCHED; PG8_LDA(At, 0, 0); PG8_STAGE(PG8_SA(1, 1), a1 + hstep, voffA);
            PG8_WAIT_V(8); PG8_WAIT_L(0); PG8_BAR; PG8_MMA(0, 0, At, B0); PG8_MMA(0, 1, At, B1); PG8_BAR; PG8_SCHED;
            PG8_LDA(At, 0, 1); PG8_STAGE(PG8_SB(0, 0), b2, voffB); PG8_STAGE(PG8_SB(0, 1), b2 + hstep, voffB); PG8_STAGE(PG8_SA(0, 0), a2, voffA);
            PG8_WAIT_V(8); PG8_WAIT_L(0); PG8_BAR; PG8_MMA(1, 0, At, B0); PG8_MMA(1, 1, At, B1); PG8_BAR; PG8_SCHED;
            PG8_LDB(B0, 1, 0); PG8_LDB(B1, 1, 1); PG8_SCHED; PG8_LDA(At, 1, 0); PG8_STAGE(PG8_SA(0, 1), a2 + hstep, voffA);
            PG8_WAIT_V(8); PG8_WAIT_L(0); PG8_BAR; PG8_MMA(0, 0, At, B0); PG8_MMA(0, 1, At, B1); PG8_BAR; PG8_SCHED;
            PG8_LDA(At, 1, 1); PG8_STAGE(PG8_SB(1, 0), b3, voffB); PG8_STAGE(PG8_SB(1, 1), b3 + hstep, voffB); PG8_STAGE(PG8_SA(1, 0), a3, voffA);
            PG8_WAIT_V(8); PG8_WAIT_L(0); PG8_BAR; PG8_MMA(1, 0, At, B0); PG8_MMA(1, 1, At, B1); PG8_BAR; PG8_SCHED;
            } else {
            PG8_LDB(B0, 0, 0); PG8_SCHED; PG8_LDA(At, 0, 0); PG8_STAGE(PG8_SA(1, 1), a1 + hstep, voffA);
            PG8_WAIT_L(8); PG8_BAR; PG8_WAIT_L(0); PG8_MMA(0, 0, At, B0); PG8_BAR; PG8_SCHED;
            PG8_LDB(B1, 0, 1); PG8_STAGE(PG8_SB(0, 0), b2, voffB);
            PG8_BAR; PG8_WAIT_L(0); PG8_MMA(0, 1, At, B1); PG8_BAR;
            PG8_LDA(At, 0, 1); PG8_STAGE(PG8_SA(0, 0), a2, voffA);
            PG8_BAR; PG8_WAIT_L(0); PG8_MMA(1, 0, At, B0); PG8_BAR; PG8_SCHED;
            PG8_STAGE(PG8_SB(0, 1), b2 + hstep, voffB);
            PG8_WAIT_V(6); PG8_BAR; PG8_MMA(1, 1, At, B1); PG8_BAR;
            PG8_LDB(B0, 1, 0); PG8_SCHED; PG8_LDA(At, 1, 0); PG8_STAGE(PG8_SA(0, 1), a2 + hstep, voffA);
            PG8_WAIT_L(8); PG8_BAR; PG8_WAIT_L(0); PG8_MMA(0, 0, At, B0); PG8_BAR; PG8_SCHED;
            PG8_LDB(B1, 1, 1); PG8_STAGE(PG8_SB(1, 0), b3, voffB);
            PG8_BAR; PG8_WAIT_L(0); PG8_MMA(0, 1, At, B1); PG8_BAR;
            PG8_LDA(At, 1, 1); PG8_STAGE(PG8_SA(1, 0), a3, voffA);
            PG8_BAR; PG8_WAIT_L(0); PG8_MMA(1, 0, At, B0); PG8_BAR; PG8_SCHED;
            PG8_STAGE(PG8_SB(1, 1), b3 + hstep, voffB);
            PG8_WAIT_V(6); PG8_BAR; PG8_MMA(1, 1, At, B1); PG8_BAR;
            }
        }
        if constexpr (ALIGN_EPI) { if (wr == 0) PG8_BAR; }
        if constexpr (!Epi::AFTER_DRAIN) { E(acc, cur, wr, wc, fr, fq); S.done(cur); }
        if (!has_next) break;
#pragma unroll
        for (int a = 0; a < 2; ++a)
#pragma unroll
            for (int b = 0; b < 2; ++b)
#pragma unroll
                for (int m = 0; m < 4; ++m)
#pragma unroll
                    for (int n = 0; n < 2; ++n) acc[a][b][m][n] = (f32x4){0.f, 0.f, 0.f, 0.f};
        cur = nxt; cA = nA; cB = nB; ++ui;
        if constexpr (ALIGN_EPI) { if (wr == 1) PG8_BAR; }
    }
    PG8_WAIT_V(0);
    if constexpr (!ALIGN_EPI) { if (wr == 0) PG8_BAR; }
    PG8_BAR;
    if constexpr (Epi::AFTER_DRAIN) { E.fused(acc, cur, wr, wc, fr, fq, lds, wid, lane); S.done(cur); }
#undef PG8_SA
#undef PG8_SB
#undef PG8_STAGE
#undef PG8_LDA
#undef PG8_LDB
#undef PG8_MMA
#undef PG8_WAIT_V
#undef PG8_WAIT_L
#undef PG8_BAR
#undef PG8_SCHED
}
}
typedef float f32x2 __attribute__((ext_vector_type(2)));
#define GAS __attribute__((address_space(1)))
#define LAS __attribute__((address_space(3)))
typedef unsigned short bf16;
typedef unsigned v4u __attribute__((ext_vector_type(4)));
typedef float f32x4 __attribute__((ext_vector_type(4)));
typedef short bf16x8 __attribute__((ext_vector_type(8)));
typedef GAS unsigned gu32;
typedef GAS unsigned long long gu64;
#define RLX_AGENT __ATOMIC_RELAXED, __HIP_MEMORY_SCOPE_AGENT
#define LDS_WAIT() asm volatile("s_waitcnt lgkmcnt(0)" ::: "memory")
#define VM_WAIT() asm volatile("s_waitcnt vmcnt(0)" ::: "memory")
__device__ __forceinline__ unsigned long long rt() { return __builtin_amdgcn_s_memrealtime(); }
__device__ __forceinline__ unsigned f2bf(float f) { unsigned u = __builtin_bit_cast(unsigned, f); return (u + 0x7fffu + ((u >> 16) & 1u)) >> 16; }
__device__ __forceinline__ unsigned pk2(float lo, float hi) { return f2bf(lo) | (f2bf(hi) << 16); }
#define XB_TMO      128
#define XB_XCNT(j)  (256  + 64 * (j))
#define XB_XSUB(j)  (1280 + 64 * (j))
#define XB_XGEN(j)  (2304 + 64 * (j))
#define XB_TOP      3328
#define XB_TOPGEN   3392
#define XCD_BAR_WORDS 3456
#define XB_SPIN_CAP (1u << 18)

__device__ __forceinline__ unsigned xb_ld(unsigned* p)              { return __hip_atomic_load(p, __ATOMIC_RELAXED, __HIP_MEMORY_SCOPE_AGENT); }
__device__ __forceinline__ unsigned xb_add(unsigned* p, unsigned v) { return __hip_atomic_fetch_add(p, v, __ATOMIC_RELAXED, __HIP_MEMORY_SCOPE_AGENT); }
__device__ __forceinline__ unsigned xb_xcc_id() { return (unsigned)__builtin_amdgcn_s_getreg((3 << 11) | 20) & 0xFu; }
#define XB_SPIN(cond, bar) do { unsigned _sp = 0; while (cond) { __builtin_amdgcn_s_sleep(1); \
    if ((++_sp & 255u) == 0u) { if (xb_ld(&(bar)[XB_TMO])) break; if (_sp > XB_SPIN_CAP) { atomicAdd(&(bar)[XB_TMO], 1u); break; } } } } while (0)

struct XcdBarrier {
    unsigned* bar; unsigned x;
    volatile LAS unsigned* st;
};

__device__ __forceinline__ XcdBarrier xcd_barrier_post(unsigned* bar, volatile LAS unsigned* st) {
    XcdBarrier b; b.bar = bar; b.x = xb_xcc_id(); b.st = st;
    if (threadIdx.x == 0) (void)xb_add(&bar[XB_XCNT(b.x)], 1u);
    return b;
}
__device__ __forceinline__ void xcd_barrier_complete(unsigned* bar, unsigned x, unsigned& nloc, unsigned& nx) {
    const unsigned G = gridDim.x * gridDim.y * gridDim.z;
    unsigned sum, cnt, mine, sp = 0u;
    for (;;) {
        sum = 0u; cnt = 0u; mine = 0u;
#pragma unroll
        for (unsigned j = 0; j < 16; ++j) { const unsigned c = xb_ld(&bar[XB_XCNT(j)]); sum += c; cnt += (c > 0u) ? 1u : 0u; mine = (j == x) ? c : mine; }
        if (sum == G) break;
        __builtin_amdgcn_s_sleep(1);
        if ((++sp & 255u) == 0u) { if (xb_ld(&bar[XB_TMO])) break; if (sp > XB_SPIN_CAP) { atomicAdd(&bar[XB_TMO], 1u); break; } }
    }
    nloc = mine > 0u ? mine : 1u; nx = cnt > 0u ? cnt : 1u;
}

__device__ __forceinline__ void xcd_barrier(const XcdBarrier& b) {
    asm volatile("s_waitcnt vmcnt(0)" ::: "memory");
    __syncthreads();
    if (threadIdx.x == 0) {
        unsigned* bar = b.bar;
        __builtin_amdgcn_s_waitcnt(0);
        unsigned nloc = b.st[0], nx = b.st[1];
        if (nloc == 0u) { xcd_barrier_complete(bar, b.x, nloc, nx); b.st[0] = nloc; b.st[1] = nx; }
        const unsigned old = xb_add(&bar[XB_XSUB(b.x)], 1u);
        const unsigned gen = old / nloc;
        if (old + 1u == (gen + 1u) * nloc) {
            __builtin_amdgcn_fence(__ATOMIC_RELEASE, "agent");
            asm volatile("s_waitcnt vmcnt(0)" ::: "memory");
            const unsigned og = xb_add(&bar[XB_TOP], 1u);
            const unsigned tg = og / nx;
            if (og + 1u == (tg + 1u) * nx) xb_add(&bar[XB_TOPGEN], 1u);
            else XB_SPIN(xb_ld(&bar[XB_TOPGEN]) == tg, bar);
            __builtin_amdgcn_fence(__ATOMIC_ACQUIRE, "agent");
            xb_add(&bar[XB_XGEN(b.x)], 1u);
            asm volatile("s_waitcnt vmcnt(0)" ::: "memory");
        } else {
            XB_SPIN(xb_ld(&bar[XB_XGEN(b.x)]) == gen, bar);
            __builtin_amdgcn_fence(__ATOMIC_ACQUIRE, "agent");
            asm volatile("s_waitcnt vmcnt(0)" ::: "memory");
        }
    }
    __syncthreads();
}
constexpr int NWAVES = 8, NTHREADS = NWAVES * 64;
constexpr int BATCH = 4, SEQ = 4096, D = 2048, M = BATCH * SEQ;
constexpr int NH = 8, HD = 128, GW = 1024;
constexpr int NPROJ = 8192, NPROJ_SRC = 8208, AB_COL = 4096;
constexpr int FF = 8192;
constexpr float NORM_EPS = 1e-6f, L2_EPS = 1e-6f;
#ifndef MK_N_LAUNCHES
#define MK_N_LAUNCHES 9
#endif
constexpr int N_PHASES = 9;
constexpr int N_LAUNCHES = MK_N_LAUNCHES;

constexpr size_t MiB = 1u << 20;
constexpr size_t WS_CTL = 0, CTL_ZERO_BYTES = 1 * MiB;
constexpr size_t WS_AB = 1 * MiB;
constexpr size_t WS_WIN = 2 * MiB, WS_WOUT = 34 * MiB, WS_W1 = 42 * MiB, WS_W2 = 74 * MiB;
constexpr size_t WS_SS1 = 106 * MiB, WS_SS2 = 108 * MiB;
constexpr size_t WS_DEC = 110 * MiB, WS_BETA = WS_DEC + 512 * 1024;
constexpr size_t WS_XN = 112 * MiB;
constexpr size_t WS_Y = 176 * MiB;
constexpr size_t WS_PROJ = 240 * MiB, PROJ_SLOT = 32 * MiB;
constexpr size_t WS_END = 496 * MiB;
constexpr int CW_BAR = 4096;

constexpr int RING_BYTES = 131072, LDSCTL_OFF = RING_BYTES, MISC_OFF = LDSCTL_OFF + 320, LDS_BYTES = 147456;

__device__ __forceinline__ float wave_sum(float v) {
#pragma unroll
    for (int o = 1; o < 64; o <<= 1) v += __shfl_xor(v, o);
    return v;
}
__device__ __forceinline__ float bf_lo(unsigned u) { return __builtin_bit_cast(float, u << 16); }
__device__ __forceinline__ float bf_hi(unsigned u) { return __builtin_bit_cast(float, u & 0xffff0000u); }
__device__ __forceinline__ float sigmoidf_(float x) { return 1.0f / (1.0f + __expf(-x)); }
__device__ __forceinline__ float siluf_(float x) { return x / (1.0f + __expf(-x)); }
template <int CTRL> __device__ __forceinline__ float dpp_add(float v) {
    const int r = __builtin_amdgcn_update_dpp(0, __builtin_bit_cast(int, v), CTRL, 0xf, 0xf, true);
    return v + __builtin_bit_cast(float, r);
}
__device__ __forceinline__ float red16(float v) {
    v = dpp_add<0xB1>(v); v = dpp_add<0x4E>(v); v = dpp_add<0x141>(v); v = dpp_add<0x140>(v); return v;
}

__device__ __forceinline__ void transpose_item(const float* W, int ldw, int srccol0, int k0, bf16* WT, int ldt, int dstrow0, const float* kscale, LAS float* scr, int lane) {
#pragma unroll 8
    for (int i = 0; i < 32; ++i) { const int kk = 2 * i + (lane >> 5); float v = W[(size_t)(k0 + kk) * ldw + srccol0 + (lane & 31)]; if (kscale) v *= kscale[k0 + kk]; scr[kk * 33 + (lane & 31)] = v; }
    LDS_WAIT(); asm volatile("" ::: "memory");
    const int c = lane & 7;
#pragma unroll
    for (int j = 0; j < 4; ++j) { const int n = (lane >> 3) + 8 * j; const LAS float* s = scr + (8 * c) * 33 + n;
        v4u o; o.x = pk2(s[0 * 33], s[1 * 33]); o.y = pk2(s[2 * 33], s[3 * 33]); o.z = pk2(s[4 * 33], s[5 * 33]); o.w = pk2(s[6 * 33], s[7 * 33]);
        *(GAS v4u*)(WT + (size_t)(dstrow0 + n) * ldt + k0 + 8 * c) = o; }
    LDS_WAIT(); asm volatile("" ::: "memory");
}

struct Args { const float* in[14]; float* out; unsigned char* ws; int ph_lo, ph_hi, li, pad; };

__global__ void __launch_bounds__(NTHREADS, 2) hyb_fwd(Args args) {
    extern __shared__ __attribute__((aligned(16))) unsigned char lds_raw[];
    LAS unsigned char* lds = (LAS unsigned char*)lds_raw;
    volatile LAS unsigned* MISC = (volatile LAS unsigned*)(lds + MISC_OFF);
    const int tid = threadIdx.x, lane = tid & 63, wave = __builtin_amdgcn_readfirstlane(tid >> 6);
    const int G = gridDim.x; const int bx = blockIdx.x; const int vcu = (G % 8 == 0) ? (bx % 8) * (G / 8) + bx / 8 : bx;
    const int gw = vcu * NWAVES + wave, NGW = G * NWAVES;
    unsigned char* ws = args.ws;
    gu32* ctl = (gu32*)(ws + WS_CTL);
    const float* x = args.in[0]; const float* w_in = args.in[1]; const float* conv_w = args.in[2]; const float* a_log = args.in[3]; const float* dt_bias = args.in[4];
    const float* gdn_nw = args.in[5]; const float* lb_logits = args.in[6]; const float* hgrn_nw = args.in[7]; const float* w_out = args.in[8];
    const float* w_mix = args.in[9]; const float* w_ffn = args.in[10]; const float* w1 = args.in[11]; const float* w2 = args.in[12]; const float* w_fin = args.in[13];
    float* out = args.out;
    bf16* WIN_T = (bf16*)(ws + WS_WIN); bf16* WOUT_T = (bf16*)(ws + WS_WOUT); bf16* W1_T = (bf16*)(ws + WS_W1); bf16* W2_T = (bf16*)(ws + WS_W2);
    float* AB = (float*)(ws + WS_AB); float* SS1 = (float*)(ws + WS_SS1); float* SS2 = (float*)(ws + WS_SS2);
    float* DEC = (float*)(ws + WS_DEC); float* BETA = (float*)(ws + WS_BETA);
    bf16* XN = (bf16*)(ws + WS_XN); float* VF = (float*)(ws + WS_XN); bf16* HB = (bf16*)(ws + WS_XN);
    bf16* Y = (bf16*)(ws + WS_Y); float* FG = (float*)(ws + WS_Y);
    bf16* PROJ = (bf16*)(ws + WS_PROJ); float* OB = (float*)(ws + WS_PROJ); bf16* ACT = (bf16*)(ws + WS_PROJ);
    float* QF = out; float* KF = out + (size_t)M * GW;
#define PSLOT(i) (PROJ + (size_t)(i) * ((size_t)M * GW))

    for (int u = tid; u < (LDS_BYTES - LDSCTL_OFF) / 4; u += NTHREADS) ((LAS unsigned*)(lds + LDSCTL_OFF))[u] = 0u;
    __syncthreads();
    XcdBarrier bar; bar.bar = (unsigned*)(ctl + CW_BAR); bar.x = 0; bar.st = nullptr;
    if (N_LAUNCHES == 1) bar = xcd_barrier_post((unsigned*)(ctl + CW_BAR), MISC + 8);
    const int lo = args.ph_lo, hi = args.ph_hi;
#define IN(k) (lo <= (k) && (k) < hi)
#define SEAM(k) do { if (IN(k) && IN((k) + 1)) xcd_barrier(bar); } while (0)

    if (IN(0)) {
        {
            LAS float* scr = (LAS float*)(lds + wave * 16384);
            constexpr int I_IN = (D / 64) * (NPROJ / 32), I_OUT = (D / 64) * (D / 32), I_1 = (D / 64) * (FF / 32), I_2 = (FF / 64) * (D / 32);
            constexpr int NITEMS = I_IN + I_OUT + I_1 + I_2;
            for (int it = gw; it < NITEMS; it += NGW) {
                int r = it;
                if (r < I_IN) { const int kb = r / (NPROJ / 32), nb = r % (NPROJ / 32), n0 = 32 * nb; transpose_item(w_in, NPROJ_SRC, n0 + (n0 >= AB_COL ? 16 : 0), 64 * kb, WIN_T, D, n0, nullptr, scr, lane); continue; } r -= I_IN;
                if (r < I_OUT) { const int kb = r / (D / 32), nb = r % (D / 32); transpose_item(w_out, D, 32 * nb, 64 * kb, WOUT_T, D, 32 * nb, nullptr, scr, lane); continue; } r -= I_OUT;
                if (r < I_1) { const int kb = r / (FF / 32), nb = r % (FF / 32); transpose_item(w1, FF, 32 * nb, 64 * kb, W1_T, D, 32 * nb, w_ffn, scr, lane); continue; } r -= I_1;
                { const int kb = r / (D / 32), nb = r % (D / 32); transpose_item(w2, D, 32 * nb, 64 * kb, W2_T, FF, 32 * nb, nullptr, scr, lane); }
            }
        }
        __syncthreads();
        {
            LAS float* wab = (LAS float*)lds;
#pragma unroll
            for (int i = 0; i < 4; ++i) { const int k = tid + NTHREADS * i; const f32x4* src = (const f32x4*)(w_in + (size_t)k * NPROJ_SRC + AB_COL);
#pragma unroll
                for (int q = 0; q < 4; ++q) { const f32x4 v = src[q]; wab[(4 * q + 0) * D + k] = v[0]; wab[(4 * q + 1) * D + k] = v[1]; wab[(4 * q + 2) * D + k] = v[2]; wab[(4 * q + 3) * D + k] = v[3]; } }
            __syncthreads();
            f32x4 wm[8];
#pragma unroll
            for (int j = 0; j < 8; ++j) wm[j] = *(const f32x4*)(w_mix + 256 * j + 4 * lane);
            for (int rp = 0; rp < 4; ++rp) {
                const int m0 = gw * 8 + rp * 2;
                if (m0 >= M) break;
                f32x4 n0[8], n1[8]; float s0 = 0.f, s1 = 0.f;
#pragma unroll
                for (int j = 0; j < 8; ++j) { n0[j] = *(const f32x4*)(x + (size_t)m0 * D + 256 * j + 4 * lane); n1[j] = *(const f32x4*)(x + (size_t)(m0 + 1) * D + 256 * j + 4 * lane); }
#pragma unroll
                for (int j = 0; j < 8; ++j) { s0 += (n0[j][0] * n0[j][0] + n0[j][1] * n0[j][1]) + (n0[j][2] * n0[j][2] + n0[j][3] * n0[j][3]); s1 += (n1[j][0] * n1[j][0] + n1[j][1] * n1[j][1]) + (n1[j][2] * n1[j][2] + n1[j][3] * n1[j][3]); }
                const float r0 = 1.0f / sqrtf(wave_sum(s0) * (1.0f / D) + NORM_EPS), r1 = 1.0f / sqrtf(wave_sum(s1) * (1.0f / D) + NORM_EPS);
#pragma unroll
                for (int j = 0; j < 8; ++j) { n0[j] = n0[j] * r0 * wm[j]; n1[j] = n1[j] * r1 * wm[j];
                    *(GAS unsigned long long*)(XN + (size_t)m0 * D + 256 * j + 4 * lane) = (unsigned long long)pk2(n0[j][0], n0[j][1]) | ((unsigned long long)pk2(n0[j][2], n0[j][3]) << 32);
                    *(GAS unsigned long long*)(XN + (size_t)(m0 + 1) * D + 256 * j + 4 * lane) = (unsigned long long)pk2(n1[j][0], n1[j][1]) | ((unsigned long long)pk2(n1[j][2], n1[j][3]) << 32); }
                float acc[32];
#pragma unroll
                for (int c = 0; c < 16; ++c) { float a0 = 0.f, a1 = 0.f;
#pragma unroll
                    for (int j = 0; j < 8; ++j) { const f32x4 w4 = *(const LAS f32x4*)(wab + c * D + 256 * j + 4 * lane);
                        a0 += (n0[j][0] * w4[0] + n0[j][1] * w4[1]) + (n0[j][2] * w4[2] + n0[j][3] * w4[3]); a1 += (n1[j][0] * w4[0] + n1[j][1] * w4[1]) + (n1[j][2] * w4[2] + n1[j][3] * w4[3]); }
                    acc[c] = a0; acc[16 + c] = a1; }
#pragma unroll
                for (int i = 0; i < 16; ++i) { const bool up = (lane & 32) != 0; const float keep = up ? acc[16 + i] : acc[i], send = up ? acc[i] : acc[16 + i]; acc[i] = keep + __shfl_xor(send, 32); }
#pragma unroll
                for (int i = 0; i < 8; ++i) { const bool up = (lane & 16) != 0; const float keep = up ? acc[8 + i] : acc[i], send = up ? acc[i] : acc[8 + i]; acc[i] = keep + __shfl_xor(send, 16); }
#pragma unroll
                for (int i = 0; i < 4; ++i) { const bool up = (lane & 8) != 0; const float keep = up ? acc[4 + i] : acc[i], send = up ? acc[i] : acc[4 + i]; acc[i] = keep + __shfl_xor(send, 8); }
#pragma unroll
                for (int i = 0; i < 2; ++i) { const bool up = (lane & 4) != 0; const float keep = up ? acc[2 + i] : acc[i], send = up ? acc[i] : acc[2 + i]; acc[i] = keep + __shfl_xor(send, 4); }
                { const bool up = (lane & 2) != 0; const float keep = up ? acc[1] : acc[0], send = up ? acc[0] : acc[1]; acc[0] = keep + __shfl_xor(send, 2); }
                acc[0] += __shfl_xor(acc[0], 1);
                if ((lane & 1) == 0) { const int i = lane >> 1; AB[(size_t)(m0 + (i >> 4)) * 16 + (i & 15)] = acc[0]; }
            }
        }
        __syncthreads();
    }
    SEAM(0);

    if (IN(1)) {
        pg8::Gemm g{XN, WIN_T, M, NPROJ, D}; pg8::StaticOrder S; S.init(M, NPROJ, G, bx);
        pg8::EpiBf16Split E{PROJ, GW, GW, (size_t)M * GW};
        pg8::gemm_phase<pg8::EpiBf16Split, pg8::StaticOrder, true, true>(lds, g, S, E);
    }
    SEAM(1);

    if (IN(2)) {
        {
            const int h = gw & 7, m0 = (gw >> 3) * 64, t0 = m0 & (SEQ - 1);
            if (m0 < M) {
                float cw[3][4][2];
#pragma unroll
                for (int X = 0; X < 3; ++X)
#pragma unroll
                    for (int j = 0; j < 4; ++j) { const float* p = conv_w + (size_t)j * (3 * GW) + X * GW + h * HD + 2 * lane; cw[X][j][0] = p[0]; cw[X][j][1] = p[1]; }
                float r[3][4][2];
#pragma unroll
                for (int X = 0; X < 3; ++X)
#pragma unroll
                    for (int j = 0; j < 3; ++j) { unsigned u = 0u; if (t0 - 3 + j >= 0) u = *(const unsigned*)(PSLOT(X) + (size_t)(m0 - 3 + j) * GW + h * HD + 2 * lane); r[X][j][0] = bf_lo(u); r[X][j][1] = bf_hi(u); }
                const float A = __expf(a_log[h]), dtb = dt_bias[h];
                for (int i = 0; i < 64; ++i) {
                    const int m = m0 + i; float o[3][2];
#pragma unroll
                    for (int X = 0; X < 3; ++X) { const unsigned u = *(const unsigned*)(PSLOT(X) + (size_t)m * GW + h * HD + 2 * lane); r[X][3][0] = bf_lo(u); r[X][3][1] = bf_hi(u);
#pragma unroll
                        for (int e = 0; e < 2; ++e) { const float c = (cw[X][0][e] * r[X][0][e] + cw[X][1][e] * r[X][1][e]) + (cw[X][2][e] * r[X][2][e] + cw[X][3][e] * r[X][3][e]); o[X][e] = siluf_(c); }
#pragma unroll
                        for (int j = 0; j < 3; ++j) { r[X][j][0] = r[X][j + 1][0]; r[X][j][1] = r[X][j + 1][1]; } }
                    const float sq = wave_sum(o[0][0] * o[0][0] + o[0][1] * o[0][1]), sk = wave_sum(o[1][0] * o[1][0] + o[1][1] * o[1][1]);
                    const float rq = (1.0f / sqrtf(sq + L2_EPS)) * 0.08838834764831845f, rk = 1.0f / sqrtf(sk + L2_EPS);
                    const size_t off = (size_t)m * GW + h * HD + 2 * lane;
                    *(f32x2*)(QF + off) = (f32x2){o[0][0] * rq, o[0][1] * rq}; *(f32x2*)(KF + off) = (f32x2){o[1][0] * rk, o[1][1] * rk}; *(f32x2*)(VF + off) = (f32x2){o[2][0], o[2][1]};
                    if (lane == 0) { const float ar = AB[(size_t)m * 16 + h], br = AB[(size_t)m * 16 + 8 + h]; const float z = ar + dtb; const float sp = fmaxf(z, 0.f) + log1pf(__expf(-fabsf(z)));
                        DEC[(size_t)m * 8 + h] = __expf(-A * sp); BETA[(size_t)m * 8 + h] = sigmoidf_(br); }
                }
            }
        }
        {
            const int gt = vcu * NTHREADS + tid, NGT = G * NTHREADS; constexpr int NIT = M * GW / 8;
            const int c0 = (gt * 8) & (GW - 1); float lb[8];
#pragma unroll
            for (int e = 0; e < 8; ++e) lb[e] = 1.0f / (1.0f + __expf(lb_logits[GW + c0 + e] - lb_logits[c0 + e]));
            if ((NGT * 8) % GW == 0) {
                for (int it = gt; it < NIT; it += NGT) {
                    const size_t off = (size_t)it * 8;
                    const v4u fu = *(const v4u*)(PSLOT(5) + off); const v4u qu = *(const v4u*)(PSLOT(4) + off);
                    float f[8] = {bf_lo(fu.x), bf_hi(fu.x), bf_lo(fu.y), bf_hi(fu.y), bf_lo(fu.z), bf_hi(fu.z), bf_lo(fu.w), bf_hi(fu.w)};
                    float q[8] = {bf_lo(qu.x), bf_hi(qu.x), bf_lo(qu.y), bf_hi(qu.y), bf_lo(qu.z), bf_hi(qu.z), bf_lo(qu.w), bf_hi(qu.w)};
#pragma unroll
                    for (int e = 0; e < 8; ++e) { f[e] = lb[e] + (1.0f - lb[e]) * sigmoidf_(f[e]); q[e] = siluf_(q[e]); }
                    *(f32x4*)(FG + off) = (f32x4){f[0], f[1], f[2], f[3]}; *(f32x4*)(FG + off + 4) = (f32x4){f[4], f[5], f[6], f[7]};
                    v4u qo; qo.x = pk2(q[0], q[1]); qo.y = pk2(q[2], q[3]); qo.z = pk2(q[4], q[5]); qo.w = pk2(q[6], q[7]);
                    *(v4u*)(PSLOT(4) + off) = qo;
                }
            }
        }
    }
    SEAM(2);

    if (IN(3)) {
        const int sub = lane & 15, cq = lane >> 4;
        if (wave < 4) {
            const int w = vcu * 4 + wave;
            for (int task = w; task < 32 * 32; task += G * 4) {
                const int bh = task >> 5, cg = task & 31, b = bh >> 3, h = bh & 7, e = 4 * cg + cq;
                const size_t rowbase = (size_t)b * SEQ;
                float s[8];
#pragma unroll
                for (int d = 0; d < 8; ++d) s[d] = 0.f;
                const float* kp = KF + rowbase * GW + h * HD + 8 * sub; const float* qp = QF + rowbase * GW + h * HD + 8 * sub;
                float* vp = VF + rowbase * GW + h * HD + e; const float* ap = DEC + rowbase * 8 + h; const float* bp = BETA + rowbase * 8 + h;
                f32x4 kc0 = *(const f32x4*)kp, kc1 = *(const f32x4*)(kp + 4), qc0 = *(const f32x4*)qp, qc1 = *(const f32x4*)(qp + 4); float vc = *vp, ac = *ap, bc = *bp;
                for (int t = 0; t < SEQ; ++t) {
                    const int tn = (t + 1 < SEQ) ? t + 1 : t;
                    const f32x4 kn0 = *(const f32x4*)(kp + (size_t)tn * GW), kn1 = *(const f32x4*)(kp + (size_t)tn * GW + 4), qn0 = *(const f32x4*)(qp + (size_t)tn * GW), qn1 = *(const f32x4*)(qp + (size_t)tn * GW + 4);
                    const float vn = vp[(size_t)tn * GW], an = ap[(size_t)tn * 8], bn = bp[(size_t)tn * 8];
                    const float k[8] = {kc0[0], kc0[1], kc0[2], kc0[3], kc1[0], kc1[1], kc1[2], kc1[3]}; const float q[8] = {qc0[0], qc0[1], qc0[2], qc0[3], qc1[0], qc1[1], qc1[2], qc1[3]};
                    float kS = 0.f, qS = 0.f, qk = 0.f;
#pragma unroll
                    for (int d = 0; d < 8; ++d) { kS += k[d] * s[d]; qS += q[d] * s[d]; qk += q[d] * k[d]; }
                    kS = red16(kS); qS = red16(qS); qk = red16(qk);
                    const float u = bc * (vc - ac * kS);
#pragma unroll
                    for (int d = 0; d < 8; ++d) s[d] = ac * s[d] + u * k[d];
                    if (sub == 0) vp[(size_t)t * GW] = ac * qS + u * qk;
                    kc0 = kn0; kc1 = kn1; qc0 = qn0; qc1 = qn1; vc = vn; ac = an; bc = bn;
                }
            }
        } else {
            const int w = vcu * 4 + (wave - 4);
            for (int task = w; task < 32 * 32; task += G * 4) {
                const int bh = task >> 5, cg = task & 31, b = bh >> 3, h = bh & 7, e = 4 * cg + cq;
                const size_t rowbase = (size_t)b * SEQ;
                float s[8];
#pragma unroll
                for (int d = 0; d < 8; ++d) s[d] = 0.f;
                const float* fp = FG + rowbase * GW + h * HD + 8 * sub; const bf16* qp = PSLOT(4) + rowbase * GW + h * HD + 8 * sub;
                const bf16* vp = PSLOT(6) + rowbase * GW + h * HD + e; float* op = OB + rowbase * GW + h * HD + e;
                f32x4 fc0 = *(const f32x4*)fp, fc1 = *(const f32x4*)(fp + 4); v4u qc = *(const v4u*)qp; unsigned vc = *vp;
                for (int t = 0; t < SEQ; ++t) {
                    const int tn = (t + 1 < SEQ) ? t + 1 : t;
                    const f32x4 fn0 = *(const f32x4*)(fp + (size_t)tn * GW), fn1 = *(const f32x4*)(fp + (size_t)tn * GW + 4); const v4u qn = *(const v4u*)(qp + (size_t)tn * GW); const unsigned vn = vp[(size_t)tn * GW];
                    const float f[8] = {fc0[0], fc0[1], fc0[2], fc0[3], fc1[0], fc1[1], fc1[2], fc1[3]};
                    const float q[8] = {bf_lo(qc.x), bf_hi(qc.x), bf_lo(qc.y), bf_hi(qc.y), bf_lo(qc.z), bf_hi(qc.z), bf_lo(qc.w), bf_hi(qc.w)};
                    const float v = __builtin_bit_cast(float, vc << 16);
                    float o = 0.f;
#pragma unroll
                    for (int d = 0; d < 8; ++d) { s[d] = f[d] * s[d] + (1.0f - f[d]) * v; o += q[d] * s[d]; }
                    o = red16(o);
                    if (sub == 0) op[(size_t)t * GW] = o;
                    fc0 = fn0; fc1 = fn1; qc = qn; vc = vn;
                }
            }
        }
    }
    SEAM(3);

    if (IN(4)) {
        constexpr int NTASK = M * 16;
        for (int task = gw * 128; task < NTASK && task < gw * 128 + 128; ++task) {
            const int m = task >> 4, hs = task & 15, h = hs & 7; const bool isb = hs >= 8;
            const size_t off = (size_t)m * GW + h * HD + 2 * lane;
            const f32x2 o = *(const f32x2*)((isb ? OB : VF) + off);
            const unsigned gu = *(const unsigned*)((isb ? PSLOT(7) : PSLOT(3)) + off);
            const float* nw = (isb ? hgrn_nw : gdn_nw) + 2 * lane;
            const float ms = wave_sum(o[0] * o[0] + o[1] * o[1]) * (1.0f / HD); const float r = 1.0f / sqrtf(ms + NORM_EPS);
            const float y0 = o[0] * r * nw[0] * siluf_(bf_lo(gu)), y1 = o[1] * r * nw[1] * siluf_(bf_hi(gu));
            *(unsigned*)(Y + (size_t)m * D + hs * HD + 2 * lane) = pk2(y0, y1);
        }
    }
    SEAM(4);

    if (IN(5)) {
        pg8::Gemm g{Y, WOUT_T, M, D, D}; pg8::StaticOrder S; S.init(M, D, G, bx);
        pg8::EpiResid<true> E{x, out, HB, SS1, D};
        pg8::gemm_phase<pg8::EpiResid<true>, pg8::StaticOrder, true, true>(lds, g, S, E);
    }
    SEAM(5);

    if (IN(6)) {
        pg8::Gemm g{HB, W1_T, M, FF, D}; pg8::StaticOrder S; S.init(M, FF, G, bx);
        pg8::EpiAct E{ACT, FF, SS1, 1.0f / D, NORM_EPS};
        pg8::gemm_phase<pg8::EpiAct, pg8::StaticOrder, true, true>(lds, g, S, E);
    }
    SEAM(6);

    if (IN(7)) {
        pg8::Gemm g{ACT, W2_T, M, D, FF}; pg8::StaticOrder S; S.init(M, D, G, bx);
        pg8::EpiResid<false> E{out, out, nullptr, SS2, D};
        pg8::gemm_phase<pg8::EpiResid<false>, pg8::StaticOrder, true, true>(lds, g, S, E);
    }
    SEAM(7);

    if (IN(8)) {
        f32x4 wf[8];
#pragma unroll
        for (int j = 0; j < 8; ++j) wf[j] = *(const f32x4*)(w_fin + 256 * j + 4 * lane);
        for (int m = gw; m < M; m += NGW) {
            const float p = (lane < 32) ? SS2[(size_t)m * 32 + lane] : 0.f; const float r = 1.0f / sqrtf(wave_sum(p) * (1.0f / D) + NORM_EPS);
            f32x4* rowp = (f32x4*)(out + (size_t)m * D) + lane;
#pragma unroll
            for (int j = 0; j < 8; ++j) rowp[64 * j] = rowp[64 * j] * r * wf[j];
        }
    }
#undef IN
#undef SEAM
#undef PSLOT
}

extern "C" void kernel_launch(void* const* d_in, const int* in_sizes, int n_in, void* d_out, int out_size, void* d_ws, size_t ws_size, hipStream_t stream) {
    static int grid = 0;
    if (grid == 0) {
        if (n_in != 14 || in_sizes[0] != M * D || out_size != M * D || ws_size < WS_END) { fprintf(stderr, "kernel_launch: shape/workspace mismatch (n_in %d, in0 %d, out %d, ws %zu)\n", n_in, n_in > 0 ? in_sizes[0] : -1, out_size, ws_size); grid = -1; return; }
        int dev = 0, cus = 0, per_cu = 0;
        if (hipGetDevice(&dev) != hipSuccess || hipDeviceGetAttribute(&cus, hipDeviceAttributeMultiprocessorCount, dev) != hipSuccess) { grid = -1; return; }
        if (hipFuncSetAttribute((const void*)hyb_fwd, hipFuncAttributeMaxDynamicSharedMemorySize, LDS_BYTES) != hipSuccess) { fprintf(stderr, "kernel_launch: hipFuncSetAttribute failed\n"); grid = -1; return; }
        if (hipOccupancyMaxActiveBlocksPerMultiprocessor(&per_cu, (const void*)hyb_fwd, NTHREADS, LDS_BYTES) != hipSuccess || per_cu < 1) { fprintf(stderr, "kernel_launch: occupancy query says %d blocks per CU\n", per_cu); grid = -1; (void)hipGetLastError(); return; }
        grid = cus;
    }
    if (grid < 0) return;
    if (hipMemsetAsync((char*)d_ws + WS_CTL, 0, CTL_ZERO_BYTES, stream) != hipSuccess) return;
    Args a{};
    for (int i = 0; i < 14; ++i) a.in[i] = (const float*)d_in[i];
    a.out = (float*)d_out; a.ws = (unsigned char*)d_ws;
    for (int li = 0; li < N_LAUNCHES; ++li) {
        a.ph_lo = (N_LAUNCHES == 1) ? 0 : li; a.ph_hi = (N_LAUNCHES == 1) ? N_PHASES : li + 1; a.li = li;
        hipLaunchKernelGGL(hyb_fwd, dim3(grid), dim3(NTHREADS), LDS_BYTES, stream, a);
        const hipError_t le = hipPeekAtLastError();
        if (le != hipSuccess) { fprintf(stderr, "kernel_launch: launch %d failed: %s\n", li, hipGetErrorName(le)); break; }
    }
}
```

```cpp
#include <hip/hip_runtime.h>
#include <cstdio>
#include <cstdint>
namespace pg8 {
#define PG8_LAS __attribute__((address_space(3)))
typedef unsigned short bf16_t;
typedef short bf16x8 __attribute__((ext_vector_type(8)));
typedef float f32x4 __attribute__((ext_vector_type(4)));
typedef unsigned u32x4 __attribute__((ext_vector_type(4)));
constexpr int BM = 256, BK = 64, HALF = 128, HTB = HALF * BK * 2  , STAGE_BYTES = 8 * HTB, NXCD = 8, WGM = 8;

__host__ __device__ __forceinline__ int lds_byte(int r, int c) { const int st = (r >> 4) * 2 + (c >> 5), rr = r & 15, cc = c & 31, ob = rr * 64 + cc * 2; return st * 1024 + (ob ^ (((ob >> 9) & 1) << 5)); }
__host__ __device__ __forceinline__ void stage_rc(int b, int& R, int& C) { const int st = b / 1024, sb = b % 1024, swz = sb ^ (((sb >> 9) & 1) << 5); R = (st >> 1) * 16 + swz / 64; C = (st & 1) * 32 + (swz % 64) / 2; }
__host__ __device__ __forceinline__ int perm32(int rho) { const int n = rho >> 4, i = rho & 15; return 8 * (i >> 2) + 4 * n + (i & 3); }

struct Unit { int pm, pn; };
struct Gemm { const bf16_t* A; const bf16_t* Bt; int M, N, K; };

struct StaticOrder {
    int nM, nN, nwg, G, c;
    __host__ __device__ void init(int M, int N, int G_, int c_) { nM = M / BM; nN = N / BM; nwg = nM * nN; G = G_; c = c_; }
    __host__ __device__ bool next(int i, Unit& u) const {
        const long L = (long)i * G + c; if (L >= nwg) return false;
        int wgid = (int)L; { const int q = nwg / NXCD, r = nwg % NXCD, xcd = wgid % NXCD, off = wgid / NXCD; wgid = (xcd < r ? xcd * (q + 1) : r * (q + 1) + (xcd - r) * q) + off; }
        const int nig = WGM * nN, gid = wgid / nig, fm = gid * WGM, gsz = (nM - fm) < WGM ? (nM - fm) : WGM;
        u.pm = fm + ((wgid % nig) % gsz); u.pn = (wgid % nig) / gsz; return true;
    }
    __device__ __forceinline__ void a_ready(const Unit&) const {}
    __device__ __forceinline__ void done(const Unit&) const {}
};

__device__ __forceinline__ unsigned cvt_pk_bf16(float lo, float hi) { unsigned r; asm volatile("v_cvt_pk_bf16_f32 %0, %1, %2" : "=v"(r) : "v"(lo), "v"(hi)); return r; }
typedef float f32x2 __attribute__((ext_vector_type(2)));
struct EpiBf16Split {
    static constexpr bool PERM = true, AFTER_DRAIN = false;
    bf16_t* O; int ldc; int split_cols; size_t split_stride;
    __device__ __forceinline__ void operator()(const f32x4 (&acc)[2][2][4][2], const Unit& u, int wr, int wc, int fr, int fq) const {
        const int row0 = u.pm * BM + wr * 64 + fr; int colt = u.pn * BM; bf16_t* base = O;
        { const int t = colt / split_cols; base += (size_t)t * split_stride; colt -= t * split_cols; }
        const int col0 = colt + wc * 32 + 8 * fq;
#pragma unroll
        for (int ai = 0; ai < 2; ++ai)
#pragma unroll
            for (int m = 0; m < 4; ++m) { bf16_t* rowp = base + (size_t)(row0 + ai * HALF + m * 16) * ldc + col0;
#pragma unroll
                for (int bj = 0; bj < 2; ++bj) { const f32x4 v0 = acc[ai][bj][m][0], v1 = acc[ai][bj][m][1];
                    u32x4 w; w.x = cvt_pk_bf16(v0[0], v0[1]); w.y = cvt_pk_bf16(v0[2], v0[3]); w.z = cvt_pk_bf16(v1[0], v1[1]); w.w = cvt_pk_bf16(v1[2], v1[3]);
                    *(u32x4*)(rowp + bj * HALF) = w; } }
    }
};
template <bool WRITE_BF16> struct EpiResid {
    static constexpr bool PERM = true, AFTER_DRAIN = false;
    const float* base; float* out; bf16_t* hb; float* ss; int ldc;
    __device__ __forceinline__ void operator()(const f32x4 (&acc)[2][2][4][2], const Unit& u, int wr, int wc, int fr, int fq) const {
        const int row0 = u.pm * BM + wr * 64 + fr, col0 = u.pn * BM + wc * 32 + 8 * fq;
#pragma unroll
        for (int ai = 0; ai < 2; ++ai)
#pragma unroll
            for (int m = 0; m < 4; ++m) { const int row = row0 + ai * HALF + m * 16; const size_t off = (size_t)row * ldc + col0; float sq = 0.f;
#pragma unroll
                for (int bj = 0; bj < 2; ++bj) {
                    const f32x4 b0 = *(const f32x4*)(base + off + bj * HALF), b1 = *(const f32x4*)(base + off + bj * HALF + 4);
                    const f32x4 v0 = acc[ai][bj][m][0] + b0, v1 = acc[ai][bj][m][1] + b1;
                    sq += (v0[0] * v0[0] + v0[1] * v0[1]) + (v0[2] * v0[2] + v0[3] * v0[3]) + (v1[0] * v1[0] + v1[1] * v1[1]) + (v1[2] * v1[2] + v1[3] * v1[3]);
                    *(f32x4*)(out + off + bj * HALF) = v0; *(f32x4*)(out + off + bj * HALF + 4) = v1;
                    if (WRITE_BF16) { u32x4 w; w.x = cvt_pk_bf16(v0[0], v0[1]); w.y = cvt_pk_bf16(v0[2], v0[3]); w.z = cvt_pk_bf16(v1[0], v1[1]); w.w = cvt_pk_bf16(v1[2], v1[3]);
                        *(u32x4*)(hb + off + bj * HALF) = w; } }
                sq += __shfl_xor(sq, 16); sq += __shfl_xor(sq, 32);
                if (fq == 0) ss[(size_t)row * 32 + u.pn * 4 + wc] = sq;
                if (m & 1) asm volatile("" ::: "memory"); }
    }
};
struct EpiResidToBf {
    static constexpr bool PERM = true, AFTER_DRAIN = false;
    const float* base; bf16_t* hb; float* ss; int ldc;
    __device__ __forceinline__ void operator()(const f32x4 (&acc)[2][2][4][2], const Unit& u, int wr, int wc, int fr, int fq) const {
        const int row0 = u.pm * BM + wr * 64 + fr, col0 = u.pn * BM + wc * 32 + 8 * fq;
#pragma unroll
        for (int ai = 0; ai < 2; ++ai)
#pragma unroll
            for (int m = 0; m < 4; ++m) { const int row = row0 + ai * HALF + m * 16; const size_t off = (size_t)row * ldc + col0; float sq = 0.f;
#pragma unroll
                for (int bj = 0; bj < 2; ++bj) {
                    const f32x4 b0 = *(const f32x4*)(base + off + bj * HALF), b1 = *(const f32x4*)(base + off + bj * HALF + 4);
                    const f32x4 v0 = acc[ai][bj][m][0] + b0, v1 = acc[ai][bj][m][1] + b1;
                    sq += (v0[0] * v0[0] + v0[1] * v0[1]) + (v0[2] * v0[2] + v0[3] * v0[3]) + (v1[0] * v1[0] + v1[1] * v1[1]) + (v1[2] * v1[2] + v1[3] * v1[3]);
                    u32x4 w; w.x = cvt_pk_bf16(v0[0], v0[1]); w.y = cvt_pk_bf16(v0[2], v0[3]); w.z = cvt_pk_bf16(v1[0], v1[1]); w.w = cvt_pk_bf16(v1[2], v1[3]);
                    *(u32x4*)(hb + off + bj * HALF) = w; }
                sq += __shfl_xor(sq, 16); sq += __shfl_xor(sq, 32);
                if (fq == 0) ss[(size_t)row * 32 + u.pn * 4 + wc] = sq;
                if (m & 1) asm volatile("" ::: "memory"); }
    }
};
struct EpiResidFromBf {
    static constexpr bool PERM = true, AFTER_DRAIN = false;
    bf16_t* hb; float* ss; int ldc;
    __device__ __forceinline__ void operator()(const f32x4 (&acc)[2][2][4][2], const Unit& u, int wr, int wc, int fr, int fq) const {
        const int row0 = u.pm * BM + wr * 64 + fr, col0 = u.pn * BM + wc * 32 + 8 * fq;
#pragma unroll
        for (int ai = 0; ai < 2; ++ai)
#pragma unroll
            for (int m = 0; m < 4; ++m) { const int row = row0 + ai * HALF + m * 16; const size_t off = (size_t)row * ldc + col0; float sq = 0.f;
#pragma unroll
                for (int bj = 0; bj < 2; ++bj) {
                    const u32x4 hw = *(const u32x4*)(hb + off + bj * HALF);
                    const f32x4 b0 = {__uint_as_float(hw.x << 16), __uint_as_float(hw.x & 0xffff0000u), __uint_as_float(hw.y << 16), __uint_as_float(hw.y & 0xffff0000u)};
                    const f32x4 b1 = {__uint_as_float(hw.z << 16), __uint_as_float(hw.z & 0xffff0000u), __uint_as_float(hw.w << 16), __uint_as_float(hw.w & 0xffff0000u)};
                    const f32x4 v0 = acc[ai][bj][m][0] + b0, v1 = acc[ai][bj][m][1] + b1;
                    sq += (v0[0] * v0[0] + v0[1] * v0[1]) + (v0[2] * v0[2] + v0[3] * v0[3]) + (v1[0] * v1[0] + v1[1] * v1[1]) + (v1[2] * v1[2] + v1[3] * v1[3]);
                    u32x4 w; w.x = cvt_pk_bf16(v0[0], v0[1]); w.y = cvt_pk_bf16(v0[2], v0[3]); w.z = cvt_pk_bf16(v1[0], v1[1]); w.w = cvt_pk_bf16(v1[2], v1[3]);
                    *(u32x4*)(hb + off + bj * HALF) = w; }
                sq += __shfl_xor(sq, 16); sq += __shfl_xor(sq, 32);
                if (fq == 0) ss[(size_t)row * 32 + u.pn * 4 + wc] = sq;
                if (m & 1) asm volatile("" ::: "memory"); }
    }
};
struct EpiAct {
    static constexpr bool PERM = true, AFTER_DRAIN = false;
    bf16_t* O; int ldc; const float* ss; float inv_n, eps;
    __device__ __forceinline__ void operator()(const f32x4 (&acc)[2][2][4][2], const Unit& u, int wr, int wc, int fr, int fq) const {
        const int row0 = u.pm * BM + wr * 64 + fr, col0 = u.pn * BM + wc * 32 + 8 * fq;
#pragma unroll
        for (int ai = 0; ai < 2; ++ai)
#pragma unroll
            for (int m = 0; m < 4; ++m) { const int row = row0 + ai * HALF + m * 16;
                const f32x4 p0 = *(const f32x4*)(ss + (size_t)row * 32 + 8 * fq), p1 = *(const f32x4*)(ss + (size_t)row * 32 + 8 * fq + 4);
                float s = ((p0[0] + p0[1]) + (p0[2] + p0[3])) + ((p1[0] + p1[1]) + (p1[2] + p1[3]));
                s += __shfl_xor(s, 16); s += __shfl_xor(s, 32);
                const float r2 = 1.0f / (s * inv_n + eps);
                bf16_t* rowp = O + (size_t)row * ldc + col0;
#pragma unroll
                for (int bj = 0; bj < 2; ++bj) { f32x4 v0 = acc[ai][bj][m][0], v1 = acc[ai][bj][m][1];
#pragma unroll
                    for (int e = 0; e < 4; ++e) { const float a = fmaxf(v0[e], 0.f), b = fmaxf(v1[e], 0.f); v0[e] = a * a * r2; v1[e] = b * b * r2; }
                    u32x4 w; w.x = cvt_pk_bf16(v0[0], v0[1]); w.y = cvt_pk_bf16(v0[2], v0[3]); w.z = cvt_pk_bf16(v1[0], v1[1]); w.w = cvt_pk_bf16(v1[2], v1[3]);
                    *(u32x4*)(rowp + bj * HALF) = w; } }
    }
};

template <class Epi, class Sched, bool ALIGN_EPI = false, bool SP2 = false>
__device__ __forceinline__ void gemm_phase(PG8_LAS unsigned char* lds, const Gemm g, const Sched& S, const Epi& E) {
    const int tid = threadIdx.x, wid = __builtin_amdgcn_readfirstlane(tid >> 6), lane = tid & 63, wr = wid >> 2, wc = wid & 3, fr = lane & 15, fq = lane >> 4;
    const int K = g.K, nt = K / BK;
    unsigned voffA[2], voffB[2];
#pragma unroll
    for (int i = 0; i < 2; ++i) { int R, C; stage_rc(tid * 16 + i * 8192, R, C); const int Rb = Epi::PERM ? ((R & ~31) + perm32(R & 31)) : R;
        voffA[i] = (unsigned)(R * K + C) * 2u; voffB[i] = (unsigned)(Rb * K + C) * 2u; }
    const size_t kstep = (size_t)(BK * 2);
    const size_t hstep = (size_t)HALF * K * 2;
    const size_t tstep = 2 * hstep;
    const unsigned ldsw = (unsigned)wid * 1024u;
    const int aoff = lds_byte(wr * 64 + fr, fq * 8), boff = lds_byte(wc * 32 + fr, fq * 8);
#define PG8_SA(b, h) (((b) * 2 + (h)) * HTB)
#define PG8_SB(b, h) ((4 + (b) * 2 + (h)) * HTB)
#define PG8_STAGE(bufoff, gbase, voff) do { _Pragma("unroll") for (int _i = 0; _i < 2; ++_i) \
        __builtin_amdgcn_global_load_lds((const unsigned*)((const char*)(gbase) + (voff)[_i]), (PG8_LAS unsigned*)(lds + (bufoff) + ldsw + _i * 8192), 16, 0, 0); } while (0)
#define PG8_LDA(dst, b, h) do { _Pragma("unroll") for (int m = 0; m < 4; ++m) _Pragma("unroll") for (int k = 0; k < 2; ++k) dst[m][k] = *(const PG8_LAS bf16x8*)(lds + PG8_SA(b, h) + aoff + m * 2048 + k * 1024); } while (0)
#define PG8_LDB(dst, b, h) do { _Pragma("unroll") for (int n = 0; n < 2; ++n) _Pragma("unroll") for (int k = 0; k < 2; ++k) dst[n][k] = *(const PG8_LAS bf16x8*)(lds + PG8_SB(b, h) + boff + n * 2048 + k * 1024); } while (0)
#define PG8_MMA(ai, bj, At, Bt) do { __builtin_amdgcn_s_setprio(1); _Pragma("unroll") for (int m = 0; m < 4; ++m) _Pragma("unroll") for (int n = 0; n < 2; ++n) _Pragma("unroll") for (int k = 0; k < 2; ++k) \
        acc[ai][bj][m][n] = __builtin_amdgcn_mfma_f32_16x16x32_bf16(Bt[n][k], At[m][k], acc[ai][bj][m][n], 0, 0, 0); __builtin_amdgcn_s_setprio(0); } while (0)
#define PG8_WAIT_V(n) asm volatile("s_waitcnt vmcnt(" #n ")" ::: "memory")
#define PG8_WAIT_L(n) asm volatile("s_waitcnt lgkmcnt(" #n ")" ::: "memory")
#define PG8_BAR __builtin_amdgcn_s_barrier()
#define PG8_SCHED __builtin_amdgcn_sched_barrier(0)
    Unit cur, nxt; int ui = 0;
    if (!S.next(0, cur)) return;
    f32x4 acc[2][2][4][2];
#pragma unroll
    for (int a = 0; a < 2; ++a)
#pragma unroll
        for (int b = 0; b < 2; ++b)
#pragma unroll
            for (int m = 0; m < 4; ++m)
#pragma unroll
                for (int n = 0; n < 2; ++n) acc[a][b][m][n] = (f32x4){0.f, 0.f, 0.f, 0.f};
    bf16x8 At[4][2], B0[2][2], B1[2][2];
    const char* cA = (const char*)g.A + (size_t)cur.pm * tstep; const char* cB = (const char*)g.Bt + (size_t)cur.pn * tstep;
    S.a_ready(cur);
    if constexpr (SP2) {
        PG8_STAGE(PG8_SB(0, 0), cB, voffB); PG8_STAGE(PG8_SB(0, 1), cB + hstep, voffB); PG8_STAGE(PG8_SA(0, 0), cA, voffA); PG8_STAGE(PG8_SA(0, 1), cA + hstep, voffA);
        if (wr == 1) PG8_BAR;
        PG8_WAIT_V(2); PG8_BAR;
        PG8_STAGE(PG8_SB(1, 0), cB + kstep, voffB); PG8_STAGE(PG8_SA(1, 0), cA + kstep, voffA); PG8_STAGE(PG8_SB(1, 1), cB + hstep + kstep, voffB);
        PG8_WAIT_V(6); PG8_BAR;
    } else {
        PG8_STAGE(PG8_SB(0, 0), cB, voffB); PG8_STAGE(PG8_SA(0, 0), cA, voffA); PG8_STAGE(PG8_SB(0, 1), cB + hstep, voffB); PG8_STAGE(PG8_SA(0, 1), cA + hstep, voffA);
        if (wr == 1) PG8_BAR;
        PG8_WAIT_V(4); PG8_BAR;
        PG8_STAGE(PG8_SB(1, 0), cB + kstep, voffB); PG8_STAGE(PG8_SA(1, 0), cA + kstep, voffA); PG8_STAGE(PG8_SB(1, 1), cB + hstep + kstep, voffB);
        PG8_WAIT_V(6); PG8_BAR;
    }
    for (;;) {
        const bool has_next = S.next(ui + 1, nxt);
        const char* nA = has_next ? (const char*)g.A + (size_t)nxt.pm * tstep : cA; const char* nB = has_next ? (const char*)g.Bt + (size_t)nxt.pn * tstep : cB;
        for (int t = 0; t < nt; t += 2) {
            const bool last = (t == nt - 2);
            const char* a1 = cA + (size_t)(t + 1) * kstep;
            const char* a2 = last ? nA : cA + (size_t)(t + 2) * kstep; const char* b2 = last ? nB : cB + (size_t)(t + 2) * kstep;
            const char* a3 = a2 + kstep; const char* b3 = b2 + kstep;
            if (last && has_next) S.a_ready(nxt);
            if constexpr (SP2) {
            PG8_LDB(B0, 0, 0); PG8_LDB(B1, 0, 1); PG8_SCHED; PG8_LDA(At, 0, 0); PG8_STAGE(PG8_SA(1, 1), a1 + hstep, voffA);
            PG8_WAIT_V(8); PG8_WAIT_L(0); PG8_BAR; PG8_MMA(0, 0, At, B0); PG8_MMA(0, 1, At, B1); PG8_BAR; PG8_SCHED;
            PG8_LDA(At, 0, 1); PG8_STAGE(PG8_SB(0, 0), b2, voffB); PG8_STAGE(PG8_SB(0, 1), b2 + hstep, voffB); PG8_STAGE(PG8_SA(0, 0), a2, voffA);
            PG8_WAIT_V(8); PG8_WAIT_L(0); PG8_BAR; PG8_MMA(1, 0, At, B0); PG8_MMA(1, 1, At, B1); PG8_BAR; PG8_SCHED;
            PG8_LDB(B0, 1, 0); PG8_LDB(B1, 1, 1); PG8_SCHED; PG8_LDA(At, 1, 0); PG8_STAGE(PG8_SA(0, 1), a2 + hstep, voffA);
            PG8_WAIT_V(8); PG8_WAIT_L(0); PG8_BAR; PG8_MMA(0, 0, At, B0); PG8_MMA(0, 1, At, B1); PG8_BAR; PG8_SCHED;
            PG8_LDA(At, 1, 1); PG8_STAGE(PG8_SB(1, 0), b3, voffB); PG8_STAGE(PG8_SB(1, 1), b3 + hstep, voffB); PG8_STAGE(PG8_SA(1, 0), a3, voffA);
            PG8_WAIT_V(8); PG8_WAIT_L(0); PG8_BAR; PG8_MMA(1, 0, At, B0); PG8_MMA(1, 1, At, B1); PG8_BAR; PG8_SCHED;
            } else {
            PG8_LDB(B0, 0, 0); PG8_SCHED; PG8_LDA(At, 0, 0); PG8_STAGE(PG8_SA(1, 1), a1 + hstep, voffA);
            PG8_WAIT_L(8); PG8_BAR; PG8_WAIT_L(0); PG8_MMA(0, 0, At, B0); PG8_BAR; PG8_SCHED;
            PG8_LDB(B1, 0, 1); PG8_STAGE(PG8_SB(0, 0), b2, voffB);
            PG8_BAR; PG8_WAIT_L(0); PG8_MMA(0, 1, At, B1); PG8_BAR;
            PG8_LDA(At, 0, 1); PG8_STAGE(PG8_SA(0, 0), a2, voffA);
            PG8_BAR; PG8_WAIT_L(0); PG8_MMA(1, 0, At, B0); PG8_BAR; PG8_SCHED;
            PG8_STAGE(PG8_SB(0, 1), b2 + hstep, voffB);
            PG8_WAIT_V(6); PG8_BAR; PG8_MMA(1, 1, At, B1); PG8_BAR;
            PG8_LDB(B0, 1, 0); PG8_SCHED; PG8_LDA(At, 1, 0); PG8_STAGE(PG8_SA(0, 1), a2 + hstep, voffA);
            PG8_WAIT_L(8); PG8_BAR; PG8_WAIT_L(0); PG8_MMA(0, 0, At, B0); PG8_BAR; PG8_SCHED;
            PG8_LDB(B1, 1, 1); PG8_STAGE(PG8_SB(1, 0), b3, voffB);
            PG8_BAR; PG8_WAIT_L(0); PG8_MMA(0, 1, At, B1); PG8_BAR;
            PG8_LDA(At, 1, 1); PG8_STAGE(PG8_SA(1, 0), a3, voffA);
            PG8_BAR; PG8_WAIT_L(0); PG8_MMA(1, 0, At, B0); PG8_BAR; PG8_SCHED;
            PG8_STAGE(PG8_SB(1, 1), b3 + hstep, voffB);
            PG8_WAIT_V(6); PG8_BAR; PG8_MMA(1, 1, At, B1); PG8_BAR;
            }
        }
        if constexpr (ALIGN_EPI) { if (wr == 0) PG8_BAR; }
        if constexpr (!Epi::AFTER_DRAIN) { E(acc, cur, wr, wc, fr, fq); S.done(cur); }
        if (!has_next) break;
#pragma unroll
        for (int a = 0; a < 2; ++a)
#pragma unroll
            for (int b = 0; b < 2; ++b)
#pragma unroll
                for (int m = 0; m < 4; ++m)
#pragma unroll
                    for (int n = 0; n < 2; ++n) acc[a][b][m][n] = (f32x4){0.f, 0.f, 0.f, 0.f};
        cur = nxt; cA = nA; cB = nB; ++ui;
        if constexpr (ALIGN_EPI) { if (wr == 1) PG8_BAR; }
    }
    PG8_WAIT_V(0);
    if constexpr (!ALIGN_EPI) { if (wr == 0) PG8_BAR; }
    PG8_BAR;
    if constexpr (Epi::AFTER_DRAIN) { E.fused(acc, cur, wr, wc, fr, fq, lds, wid, lane); S.done(cur); }
#undef PG8_SA
#undef PG8_SB
#undef PG8_STAGE
#undef PG8_LDA
#undef PG8_LDB
#undef PG8_MMA
#undef PG8_WAIT_V
#undef PG8_WAIT_L
#undef PG8_BAR
#undef PG8_SCHED
}
}
typedef float f32x2 __attribute__((ext_vector_type(2)));
#define GAS __attribute__((address_space(1)))
#define LAS __attribute__((address_space(3)))
typedef unsigned short bf16;
typedef unsigned v4u __attribute__((ext_vector_type(4)));
typedef float f32x4 __attribute__((ext_vector_type(4)));
typedef short bf16x8 __attribute__((ext_vector_type(8)));
typedef GAS unsigned gu32;
typedef GAS unsigned long long gu64;
#define RLX_AGENT __ATOMIC_RELAXED, __HIP_MEMORY_SCOPE_AGENT
#define LDS_WAIT() asm volatile("s_waitcnt lgkmcnt(0)" ::: "memory")
#define VM_WAIT() asm volatile("s_waitcnt vmcnt(0)" ::: "memory")
__device__ __forceinline__ unsigned long long rt() { return __builtin_amdgcn_s_memrealtime(); }
__device__ __forceinline__ unsigned f2bf(float f) { unsigned u = __builtin_bit_cast(unsigned, f); return (u + 0x7fffu + ((u >> 16) & 1u)) >> 16; }
__device__ __forceinline__ unsigned pk2(float lo, float hi) { return f2bf(lo) | (f2bf(hi) << 16); }
#define XB_TMO      128
#define XB_XCNT(j)  (256  + 64 * (j))
#define XB_XSUB(j)  (1280 + 64 * (j))
#define XB_XGEN(j)  (2304 + 64 * (j))
#define XB_TOP      3328
#define XB_TOPGEN   3392
#define XCD_BAR_WORDS 3456
#define XB_SPIN_CAP (1u << 18)

__device__ __forceinline__ unsigned xb_ld(unsigned* p)              { return __hip_atomic_load(p, __ATOMIC_RELAXED, __HIP_MEMORY_SCOPE_AGENT); }
__device__ __forceinline__ unsigned xb_add(unsigned* p, unsigned v) { return __hip_atomic_fetch_add(p, v, __ATOMIC_RELAXED, __HIP_MEMORY_SCOPE_AGENT); }
__device__ __forceinline__ unsigned xb_xcc_id() { return (unsigned)__builtin_amdgcn_s_getreg((3 << 11) | 20) & 0xFu; }
#define XB_SPIN(cond, bar) do { unsigned _sp = 0; while (cond) { __builtin_amdgcn_s_sleep(1); \
    if ((++_sp & 255u) == 0u) { if (xb_ld(&(bar)[XB_TMO])) break; if (_sp > XB_SPIN_CAP) { atomicAdd(&(bar)[XB_TMO], 1u); break; } } } } while (0)

struct XcdBarrier {
    unsigned* bar; unsigned x;
    volatile LAS unsigned* st;
};

__device__ __forceinline__ XcdBarrier xcd_barrier_post(unsigned* bar, volatile LAS unsigned* st) {
    XcdBarrier b; b.bar = bar; b.x = xb_xcc_id(); b.st = st;
    if (threadIdx.x == 0) (void)xb_add(&bar[XB_XCNT(b.x)], 1u);
    return b;
}
__device__ __forceinline__ void xcd_barrier_complete(unsigned* bar, unsigned x, unsigned& nloc, unsigned& nx) {
    const unsigned G = gridDim.x * gridDim.y * gridDim.z;
    unsigned sum, cnt, mine, sp = 0u;
    for (;;) {
        sum = 0u; cnt = 0u; mine = 0u;
#pragma unroll
        for (unsigned j = 0; j < 16; ++j) { const unsigned c = xb_ld(&bar[XB_XCNT(j)]); sum += c; cnt += (c > 0u) ? 1u : 0u; mine = (j == x) ? c : mine; }
        if (sum == G) break;
        __builtin_amdgcn_s_sleep(1);
        if ((++sp & 255u) == 0u) { if (xb_ld(&bar[XB_TMO])) break; if (sp > XB_SPIN_CAP) { atomicAdd(&bar[XB_TMO], 1u); break; } }
    }
    nloc = mine > 0u ? mine : 1u; nx = cnt > 0u ? cnt : 1u;
}

__device__ __forceinline__ void xcd_barrier(const XcdBarrier& b) {
    asm volatile("s_waitcnt vmcnt(0)" ::: "memory");
    __syncthreads();
    if (threadIdx.x == 0) {
        unsigned* bar = b.bar;
        __builtin_amdgcn_s_waitcnt(0);
        unsigned nloc = b.st[0], nx = b.st[1];
        if (nloc == 0u) { xcd_barrier_complete(bar, b.x, nloc, nx); b.st[0] = nloc; b.st[1] = nx; }
        const unsigned old = xb_add(&bar[XB_XSUB(b.x)], 1u);
        const unsigned gen = old / nloc;
        if (old + 1u == (gen + 1u) * nloc) {
            __builtin_amdgcn_fence(__ATOMIC_RELEASE, "agent");
            asm volatile("s_waitcnt vmcnt(0)" ::: "memory");
            const unsigned og = xb_add(&bar[XB_TOP], 1u);
            const unsigned tg = og / nx;
            if (og + 1u == (tg + 1u) * nx) xb_add(&bar[XB_TOPGEN], 1u);
            else XB_SPIN(xb_ld(&bar[XB_TOPGEN]) == tg, bar);
            __builtin_amdgcn_fence(__ATOMIC_ACQUIRE, "agent");
            xb_add(&bar[XB_XGEN(b.x)], 1u);
            asm volatile("s_waitcnt vmcnt(0)" ::: "memory");
        } else {
            XB_SPIN(xb_ld(&bar[XB_XGEN(b.x)]) == gen, bar);
            __builtin_amdgcn_fence(__ATOMIC_ACQUIRE, "agent");
            asm volatile("s_waitcnt vmcnt(0)" ::: "memory");
        }
    }
    __syncthreads();
}
constexpr int NWAVES = 8, NTHREADS = NWAVES * 64;
constexpr int BATCH = 4, SEQ = 4096, D = 2048, M = BATCH * SEQ;
constexpr int NH = 8, HD = 128, GW = 1024;
constexpr int NPROJ = 8192, NPROJ_SRC = 8208, AB_COL = 4096;
constexpr int FF = 8192;
constexpr float NORM_EPS = 1e-6f, L2_EPS = 1e-6f;
#ifndef MK_N_LAUNCHES
#define MK_N_LAUNCHES 1
#endif
enum { PH_PRO = 0, PH_G1, PH_PREP, PH_LOCAL, PH_SCAN, PH_GNORM, PH_G2, PH_G3, PH_G4, PH_FIN, N_PHASES };
constexpr int N_LAUNCHES = MK_N_LAUNCHES;

constexpr size_t MiB = 1u << 20;
constexpr size_t WS_CTL = 0, CTL_ZERO_BYTES = 1 * MiB;
constexpr size_t WS_AB = 1 * MiB;
constexpr size_t WS_WIN = 2 * MiB, WS_WOUT = 34 * MiB, WS_W1 = 42 * MiB, WS_W2 = 74 * MiB;
constexpr size_t WS_SS1 = 106 * MiB, WS_SS2 = 108 * MiB;
constexpr size_t WS_DEC = 110 * MiB, WS_BETA = WS_DEC + 512 * 1024;
constexpr size_t WS_XN = 112 * MiB;
constexpr size_t WS_Y = 176 * MiB;
constexpr size_t WS_PROJ = 240 * MiB, PROJ_SLOT = 32 * MiB;
constexpr size_t WS_DTAB = 111 * MiB;
constexpr size_t WS_HVT = WS_Y, WS_TM = WS_Y + 32 * MiB, WS_ATT = WS_Y + 48 * MiB;
constexpr size_t WS_HA = 496 * MiB;
constexpr size_t WS_END = 512 * MiB;
constexpr int CW_BAR = 4096;

constexpr int RING_BYTES = 131072, TAB_OFF = 143360  , LDSCTL_OFF = TAB_OFF + 4096, MISC_OFF = LDSCTL_OFF + 320, OST_OFF = LDSCTL_OFF + 1024  , LDS_BYTES = 163840;

typedef float f32x16 __attribute__((ext_vector_type(16)));
typedef __bf16 bf16x2_t __attribute__((ext_vector_type(2)));
#define MFMA32(a, b, c) __builtin_amdgcn_mfma_f32_32x32x16_bf16((a), (b), (c), 0, 0, 0)
__device__ __forceinline__ unsigned cvt2(float lo, float hi) { const f32x2 v = {lo, hi}; return __builtin_bit_cast(unsigned, __builtin_convertvector(v, bf16x2_t)); }
__device__ __forceinline__ int perm16(int o) { return (o & 3) | ((o & 4) << 1) | ((o & 8) >> 1); }
__device__ __forceinline__ float wave_sum(float v) {
    v += __builtin_bit_cast(float, __builtin_amdgcn_update_dpp(0, __builtin_bit_cast(int, v), 0xB1, 0xf, 0xf, true));
    v += __builtin_bit_cast(float, __builtin_amdgcn_update_dpp(0, __builtin_bit_cast(int, v), 0x4E, 0xf, 0xf, true));
    v += __builtin_bit_cast(float, __builtin_amdgcn_update_dpp(0, __builtin_bit_cast(int, v), 0x141, 0xf, 0xf, true));
    v += __builtin_bit_cast(float, __builtin_amdgcn_update_dpp(0, __builtin_bit_cast(int, v), 0x140, 0xf, 0xf, true));
    v += __builtin_bit_cast(float, __builtin_amdgcn_update_dpp(0, __builtin_bit_cast(int, v), 0x142, 0xa, 0xf, false));
    v += __builtin_bit_cast(float, __builtin_amdgcn_update_dpp(0, __builtin_bit_cast(int, v), 0x143, 0xc, 0xf, false));
    return __builtin_bit_cast(float, __builtin_amdgcn_readlane(__builtin_bit_cast(int, v), 63));
}
__device__ __forceinline__ float bf_lo(unsigned u) { return __builtin_bit_cast(float, u << 16); }
__device__ __forceinline__ float bf_hi(unsigned u) { return __builtin_bit_cast(float, u & 0xffff0000u); }
__device__ __forceinline__ float sigmoidf_(float x) { return __builtin_amdgcn_rcpf(1.0f + __expf(-x)); }
__device__ __forceinline__ float siluf_(float x) { return x * __builtin_amdgcn_rcpf(1.0f + __expf(-x)); }
template <int CTRL> __device__ __forceinline__ float dpp_add(float v) {
    const int r = __builtin_amdgcn_update_dpp(0, __builtin_bit_cast(int, v), CTRL, 0xf, 0xf, true);
    return v + __builtin_bit_cast(float, r);
}
__device__ __forceinline__ float red16(float v) {
    v = dpp_add<0xB1>(v); v = dpp_add<0x4E>(v); v = dpp_add<0x141>(v); v = dpp_add<0x140>(v); return v;
}

__device__ __forceinline__ void transpose_item(const float* W, int ldw, int srccol0, int k0, bf16* WT, int ldt, int dstrow0, const float* kscale, LAS float* scr, int lane) {
    float tv[32];
#pragma unroll
    for (int i = 0; i < 32; ++i) tv[i] = W[(size_t)(k0 + 2 * i + (lane >> 5)) * ldw + srccol0 + (lane & 31)];
    if (kscale) {
#pragma unroll
        for (int i = 0; i < 32; ++i) tv[i] *= kscale[k0 + 2 * i + (lane >> 5)];
    }
#pragma unroll
    for (int i = 0; i < 32; ++i) scr[(2 * i + (lane >> 5)) * 33 + (lane & 31)] = tv[i];
    LDS_WAIT(); asm volatile("" ::: "memory");
    const int c = lane & 7;
#pragma unroll
    for (int j = 0; j < 4; ++j) { const int n = (lane >> 3) + 8 * j; const LAS float* s = scr + (8 * c) * 33 + n;
        v4u o; o.x = pk2(s[0 * 33], s[1 * 33]); o.y = pk2(s[2 * 33], s[3 * 33]); o.z = pk2(s[4 * 33], s[5 * 33]); o.w = pk2(s[6 * 33], s[7 * 33]);
        *(GAS v4u*)(WT + (size_t)(dstrow0 + n) * ldt + k0 + 8 * c) = o; }
    LDS_WAIT(); asm volatile("" ::: "memory");
}

struct Args { const float* in[14]; float* out; unsigned char* ws; int ph_lo, ph_hi, li, pad; };

__global__ void __launch_bounds__(NTHREADS, 2) hyb_fwd(Args args) {
    extern __shared__ __attribute__((aligned(16))) unsigned char lds_raw[];
    LAS unsigned char* lds = (LAS unsigned char*)lds_raw;
    volatile LAS unsigned* MISC = (volatile LAS unsigned*)(lds + MISC_OFF);
    const int tid = threadIdx.x, lane = tid & 63, wave = __builtin_amdgcn_readfirstlane(tid >> 6);
    const int G = gridDim.x; const int bx = blockIdx.x; const int vcu = (G % 8 == 0) ? (bx % 8) * (G / 8) + bx / 8 : bx;
    const int gw = vcu * NWAVES + wave, NGW = G * NWAVES;
    unsigned char* ws = args.ws;
    gu32* ctl = (gu32*)(ws + WS_CTL);
    const float* x = args.in[0]; const float* w_in = args.in[1]; const float* conv_w = args.in[2]; const float* a_log = args.in[3]; const float* dt_bias = args.in[4];
    const float* gdn_nw = args.in[5]; const float* lb_logits = args.in[6]; const float* hgrn_nw = args.in[7]; const float* w_out = args.in[8];
    const float* w_mix = args.in[9]; const float* w_ffn = args.in[10]; const float* w1 = args.in[11]; const float* w2 = args.in[12]; const float* w_fin = args.in[13];
    float* out = args.out;
    bf16* WIN_T = (bf16*)(ws + WS_WIN); bf16* WOUT_T = (bf16*)(ws + WS_WOUT); bf16* W1_T = (bf16*)(ws + WS_W1); bf16* W2_T = (bf16*)(ws + WS_W2);
    float* AB = (float*)(ws + WS_AB); float* SS1 = (float*)(ws + WS_SS1); float* SS2 = (float*)(ws + WS_SS2);
    float* DEC = (float*)(ws + WS_DEC); float* BETA = (float*)(ws + WS_BETA);
    bf16* XN = (bf16*)(ws + WS_XN); float* VF = out; bf16* HB = (bf16*)(ws + WS_XN);
    bf16* Y = (bf16*)(ws + WS_Y);
    bf16* PROJ = (bf16*)(ws + WS_PROJ); float* OB = (float*)(ws + WS_PROJ); bf16* ACT = (bf16*)(ws + WS_PROJ);
    bf16* OA = PROJ + (size_t)2 * ((size_t)M * GW); bf16* OBH = PROJ;
    float* DTAB = (float*)(ws + WS_DTAB); bf16* HVT = (bf16*)(ws + WS_HVT); bf16* TM = (bf16*)(ws + WS_TM); bf16* ATT = (bf16*)(ws + WS_ATT); bf16* HA = (bf16*)(ws + WS_HA);
    bf16* QR = (bf16*)(ws + WS_XN); bf16* KR = QR + (size_t)M * GW; bf16* KT = (bf16*)(out + (size_t)M * GW); bf16* HKT = KT + (size_t)M * GW; float* GG = DEC;
#define PSLOT(i) (PROJ + (size_t)(i) * ((size_t)M * GW))

    for (int u = tid; u < (LDS_BYTES - LDSCTL_OFF) / 4; u += NTHREADS) ((LAS unsigned*)(lds + LDSCTL_OFF))[u] = 0u;
    __syncthreads();
    XcdBarrier bar; bar.bar = (unsigned*)(ctl + CW_BAR); bar.x = 0; bar.st = nullptr;
    if (N_LAUNCHES == 1) bar = xcd_barrier_post((unsigned*)(ctl + CW_BAR), MISC + 8);
    const int lo = args.ph_lo, hi = args.ph_hi;
#define IN(k) (lo <= (k) && (k) < hi)
#define SEAM(k) do { if (IN(k) && IN((k) + 1)) xcd_barrier(bar); } while (0)

    if (IN(PH_PRO)) {
        {
            LAS float* scr = (LAS float*)(lds + wave * 16384);
            constexpr int I_IN = (D / 64) * (NPROJ / 32);
            for (int it = gw; it < I_IN; it += NGW) { const int kb = it / (NPROJ / 32), nb = it % (NPROJ / 32), n0 = 32 * nb; transpose_item(w_in, NPROJ_SRC, n0 + (n0 >= AB_COL ? 16 : 0), 64 * kb, WIN_T, D, n0, nullptr, scr, lane); }
        }
        __syncthreads();
        {
            LAS float* wab = (LAS float*)lds;
#pragma unroll
            for (int i = 0; i < 4; ++i) { const int k = tid + NTHREADS * i; const f32x4* src = (const f32x4*)(w_in + (size_t)k * NPROJ_SRC + AB_COL);
#pragma unroll
                for (int q = 0; q < 4; ++q) { const f32x4 v = src[q]; wab[(4 * q + 0) * D + k] = v[0]; wab[(4 * q + 1) * D + k] = v[1]; wab[(4 * q + 2) * D + k] = v[2]; wab[(4 * q + 3) * D + k] = v[3]; } }
            __syncthreads();
            f32x4 wm[8];
#pragma unroll
            for (int j = 0; j < 8; ++j) wm[j] = *(const f32x4*)(w_mix + 256 * j + 4 * lane);
            for (int rp = 0; rp < 4; ++rp) {
                const int m0 = gw * 8 + rp * 2;
                if (m0 >= M) break;
                f32x4 n0[8], n1[8]; float s0 = 0.f, s1 = 0.f;
#pragma unroll
                for (int j = 0; j < 8; ++j) { n0[j] = *(const f32x4*)(x + (size_t)m0 * D + 256 * j + 4 * lane); n1[j] = *(const f32x4*)(x + (size_t)(m0 + 1) * D + 256 * j + 4 * lane); }
#pragma unroll
                for (int j = 0; j < 8; ++j) { s0 += (n0[j][0] * n0[j][0] + n0[j][1] * n0[j][1]) + (n0[j][2] * n0[j][2] + n0[j][3] * n0[j][3]); s1 += (n1[j][0] * n1[j][0] + n1[j][1] * n1[j][1]) + (n1[j][2] * n1[j][2] + n1[j][3] * n1[j][3]); }
                const float r0 = 1.0f / sqrtf(wave_sum(s0) * (1.0f / D) + NORM_EPS), r1 = 1.0f / sqrtf(wave_sum(s1) * (1.0f / D) + NORM_EPS);
#pragma unroll
                for (int j = 0; j < 8; ++j) { n0[j] = n0[j] * r0 * wm[j]; n1[j] = n1[j] * r1 * wm[j];
                    *(GAS unsigned long long*)(XN + (size_t)m0 * D + 256 * j + 4 * lane) = (unsigned long long)pk2(n0[j][0], n0[j][1]) | ((unsigned long long)pk2(n0[j][2], n0[j][3]) << 32);
                    *(GAS unsigned long long*)(XN + (size_t)(m0 + 1) * D + 256 * j + 4 * lane) = (unsigned long long)pk2(n1[j][0], n1[j][1]) | ((unsigned long long)pk2(n1[j][2], n1[j][3]) << 32); }
                float acc[32];
#pragma unroll
                for (int c = 0; c < 16; ++c) { float a0 = 0.f, a1 = 0.f;
#pragma unroll
                    for (int j = 0; j < 8; ++j) { const f32x4 w4 = *(const LAS f32x4*)(wab + c * D + 256 * j + 4 * lane);
                        a0 += (n0[j][0] * w4[0] + n0[j][1] * w4[1]) + (n0[j][2] * w4[2] + n0[j][3] * w4[3]); a1 += (n1[j][0] * w4[0] + n1[j][1] * w4[1]) + (n1[j][2] * w4[2] + n1[j][3] * w4[3]); }
                    acc[c] = a0; acc[16 + c] = a1; }
#pragma unroll
                for (int i = 0; i < 16; ++i) { const bool up = (lane & 32) != 0; const float keep = up ? acc[16 + i] : acc[i], send = up ? acc[i] : acc[16 + i]; acc[i] = keep + __shfl_xor(send, 32); }
#pragma unroll
                for (int i = 0; i < 8; ++i) { const bool up = (lane & 16) != 0; const float keep = up ? acc[8 + i] : acc[i], send = up ? acc[i] : acc[8 + i]; acc[i] = keep + __shfl_xor(send, 16); }
#pragma unroll
                for (int i = 0; i < 4; ++i) { const bool up = (lane & 8) != 0; const float keep = up ? acc[4 + i] : acc[i], send = up ? acc[i] : acc[4 + i]; acc[i] = keep + __shfl_xor(send, 8); }
#pragma unroll
                for (int i = 0; i < 2; ++i) { const bool up = (lane & 4) != 0; const float keep = up ? acc[2 + i] : acc[i], send = up ? acc[i] : acc[2 + i]; acc[i] = keep + __shfl_xor(send, 4); }
                { const bool up = (lane & 2) != 0; const float keep = up ? acc[1] : acc[0], send = up ? acc[0] : acc[1]; acc[0] = keep + __shfl_xor(send, 2); }
                acc[0] += __shfl_xor(acc[0], 1);
                if ((lane & 1) == 0) { const int i = lane >> 1; AB[(size_t)(m0 + (i >> 4)) * 16 + (i & 15)] = acc[0]; }
            }
        }
        __syncthreads();
    }
    SEAM(PH_PRO);

    if (IN(PH_G1)) {
        pg8::Gemm g{XN, WIN_T, M, NPROJ, D}; pg8::StaticOrder S; S.init(M, NPROJ, G, bx);
        pg8::EpiBf16Split E{PROJ, GW, GW, (size_t)M * GW};
        pg8::gemm_phase<pg8::EpiBf16Split, pg8::StaticOrder, true, true>(lds, g, S, E);
    }
    SEAM(PH_G1);

    if (IN(PH_PREP)) {
        for (int task = gw; task < 8 * (M / 64); task += NGW) {
            const int cidx = task >> 3, h = task & 7, bh = (cidx >> 6) * 8 + h, cs = cidx & 63, m0 = cidx * 64;
            {
                const float ar = AB[(size_t)(m0 + lane) * 16 + h], br = AB[(size_t)(m0 + lane) * 16 + 8 + h];
                const float z = ar + dt_bias[h]; const float sp = fmaxf(z, 0.f) + log1pf(__expf(-fabsf(z)));
                float gsum = -__expf(a_log[h]) * sp;
#pragma unroll
                for (int o = 1; o < 64; o <<= 1) { const float t = __shfl_up(gsum, o); if (lane >= o) gsum += t; }
                GG[(size_t)(m0 + lane) * 8 + h] = gsum; BETA[(size_t)(m0 + lane) * 8 + h] = sigmoidf_(br);
            }
            const int c0 = h * HD + 2 * lane, pc = h * HD + ((2 * lane) & ~15) + perm16((2 * lane) & 15);
            float cw[3][4][2];
#pragma unroll
            for (int X = 0; X < 3; ++X)
#pragma unroll
                for (int j = 0; j < 4; ++j) { const float* p = conv_w + (size_t)j * (3 * GW) + X * GW + c0; cw[X][j][0] = p[0]; cw[X][j][1] = p[1]; }
            float r[3][4][2];
#pragma unroll
            for (int X = 0; X < 3; ++X)
#pragma unroll
                for (int j = 0; j < 3; ++j) { unsigned u = 0u; if (cs * 64 - 3 + j >= 0) u = *(const unsigned*)(PSLOT(X) + (size_t)(m0 - 3 + j) * GW + c0); r[X][j][0] = bf_lo(u); r[X][j][1] = bf_hi(u); }
            bf16* kt = KT + (size_t)(bh * HD + 2 * lane) * SEQ + cs * 64;
            unsigned kp0[32], kp1[32];
#pragma unroll
            for (int g4 = 0; g4 < 4; ++g4) {
                float kl0 = 0.f, kl1 = 0.f;
                unsigned uc[3][16];
#pragma unroll
                for (int ii = 0; ii < 16; ++ii)
#pragma unroll
                    for (int X = 0; X < 3; ++X) uc[X][ii] = *(const unsigned*)(PSLOT(X) + (size_t)(m0 + g4 * 16 + ii) * GW + c0);
#pragma unroll
                for (int ii = 0; ii < 16; ++ii) {
                    const size_t rowo = (size_t)(m0 + g4 * 16 + ii) * GW; float o[3][2];
#pragma unroll
                    for (int X = 0; X < 3; ++X) { const unsigned u = uc[X][ii]; r[X][3][0] = bf_lo(u); r[X][3][1] = bf_hi(u);
#pragma unroll
                        for (int e = 0; e < 2; ++e) { const float c = (cw[X][0][e] * r[X][0][e] + cw[X][1][e] * r[X][1][e]) + (cw[X][2][e] * r[X][2][e] + cw[X][3][e] * r[X][3][e]); o[X][e] = siluf_(c); }
#pragma unroll
                        for (int j = 0; j < 3; ++j) { r[X][j][0] = r[X][j + 1][0]; r[X][j][1] = r[X][j + 1][1]; } }
                    const float sq = wave_sum(o[0][0] * o[0][0] + o[0][1] * o[0][1]), sk = wave_sum(o[1][0] * o[1][0] + o[1][1] * o[1][1]);
                    const float rq = __builtin_amdgcn_rsqf(sq + L2_EPS) * 0.08838834764831845f, rk = __builtin_amdgcn_rsqf(sk + L2_EPS);
                    const float k0 = o[1][0] * rk, k1 = o[1][1] * rk;
                    *(unsigned*)(QR + rowo + pc) = cvt2(o[0][0] * rq, o[0][1] * rq); *(unsigned*)(KR + rowo + pc) = cvt2(k0, k1);
                    *(f32x2*)(VF + rowo + c0) = (f32x2){o[2][0], o[2][1]};
                    if ((ii & 1) == 0) { kl0 = k0; kl1 = k1; } else { kp0[8 * g4 + (ii >> 1)] = cvt2(kl0, k0); kp1[8 * g4 + (ii >> 1)] = cvt2(kl1, k1); }
                }
            }
#pragma unroll
            for (int g4 = 0; g4 < 4; ++g4) { *(v4u*)(kt + g4 * 16) = (v4u){kp0[8 * g4 + 0], kp0[8 * g4 + 1], kp0[8 * g4 + 4], kp0[8 * g4 + 5]}; *(v4u*)(kt + g4 * 16 + 8) = (v4u){kp0[8 * g4 + 2], kp0[8 * g4 + 3], kp0[8 * g4 + 6], kp0[8 * g4 + 7]}; }
#pragma unroll
            for (int g4 = 0; g4 < 4; ++g4) { *(v4u*)(kt + SEQ + g4 * 16) = (v4u){kp1[8 * g4 + 0], kp1[8 * g4 + 1], kp1[8 * g4 + 4], kp1[8 * g4 + 5]}; *(v4u*)(kt + SEQ + g4 * 16 + 8) = (v4u){kp1[8 * g4 + 2], kp1[8 * g4 + 3], kp1[8 * g4 + 6], kp1[8 * g4 + 7]}; }
        }
        for (int task = gw; task < 8 * (M / 64); task += NGW) {
            const int cidx = task >> 3, h = task & 7, bh = (cidx >> 6) * 8 + h, cs = cidx & 63;
            const int c0 = h * HD + 2 * lane, pc = h * HD + ((2 * lane) & ~15) + perm16((2 * lane) & 15);
            const float lb0 = 1.0f / (1.0f + __expf(lb_logits[GW + c0] - lb_logits[c0])), lb1 = 1.0f / (1.0f + __expf(lb_logits[GW + c0 + 1] - lb_logits[c0 + 1]));
            float bs0 = 1.0f, bs1 = 1.0f;
            bf16* hkt = HKT + (size_t)(bh * HD + 2 * lane) * SEQ + cs * 64; bf16* hvt = HVT + (size_t)(bh * HD + 2 * lane) * SEQ + cs * 64;
            unsigned kp0[32], kp1[32], vp0[32], vp1[32];
#pragma unroll
            for (int g4 = 0; g4 < 4; ++g4) {
                float kl0 = 0.f, kl1 = 0.f; unsigned vl = 0u;
                unsigned uc[3][16];
#pragma unroll
                for (int ii = 0; ii < 16; ++ii)
#pragma unroll
                    for (int X = 0; X < 3; ++X) uc[X][ii] = *(const unsigned*)(PSLOT(4 + X) + (size_t)(cidx * 64 + g4 * 16 + ii) * GW + c0);
#pragma unroll
                for (int ii = 0; ii < 16; ++ii) {
                    const size_t rowo = (size_t)(cidx * 64 + g4 * 16 + ii) * GW;
                    const unsigned qu = uc[0][ii], fu = uc[1][ii], vu = uc[2][ii];
                    const float fg0 = lb0 + (1.0f - lb0) * sigmoidf_(bf_lo(fu)), fg1 = lb1 + (1.0f - lb1) * sigmoidf_(bf_hi(fu));
                    bs0 *= fg0; bs1 *= fg1;
                    const float qt0 = siluf_(bf_lo(qu)) * bs0, qt1 = siluf_(bf_hi(qu)) * bs1;
                    const float kt0 = (1.0f - fg0) * __builtin_amdgcn_rcpf(bs0), kt1 = (1.0f - fg1) * __builtin_amdgcn_rcpf(bs1);
                    *(unsigned*)(PSLOT(4) + rowo + pc) = cvt2(qt0, qt1); *(unsigned*)(PSLOT(5) + rowo + pc) = cvt2(kt0, kt1);
                    if ((ii & 1) == 0) { kl0 = kt0; kl1 = kt1; vl = vu; }
                    else { kp0[8 * g4 + (ii >> 1)] = cvt2(kl0, kt0); kp1[8 * g4 + (ii >> 1)] = cvt2(kl1, kt1); vp0[8 * g4 + (ii >> 1)] = (vl & 0xffffu) | (vu << 16); vp1[8 * g4 + (ii >> 1)] = (vl >> 16) | (vu & 0xffff0000u); }
                }
            }
#pragma unroll
            for (int q8 = 0; q8 < 8; ++q8) *(v4u*)(hkt + 8 * q8) = (v4u){kp0[4 * q8], kp0[4 * q8 + 1], kp0[4 * q8 + 2], kp0[4 * q8 + 3]};
#pragma unroll
            for (int q8 = 0; q8 < 8; ++q8) *(v4u*)(hkt + SEQ + 8 * q8) = (v4u){kp1[4 * q8], kp1[4 * q8 + 1], kp1[4 * q8 + 2], kp1[4 * q8 + 3]};
#pragma unroll
            for (int q8 = 0; q8 < 8; ++q8) *(v4u*)(hvt + 8 * q8) = (v4u){vp0[4 * q8], vp0[4 * q8 + 1], vp0[4 * q8 + 2], vp0[4 * q8 + 3]};
#pragma unroll
            for (int q8 = 0; q8 < 8; ++q8) *(v4u*)(hvt + SEQ + 8 * q8) = (v4u){vp1[4 * q8], vp1[4 * q8 + 1], vp1[4 * q8 + 2], vp1[4 * q8 + 3]};
            *(f32x2*)(DTAB + (size_t)task * HD + 2 * lane) = (f32x2){bs0, bs1};
        }
    }
    if (IN(PH_PREP) && IN(PH_LOCAL)) { asm volatile("s_waitcnt vmcnt(0)" ::: "memory"); __builtin_amdgcn_fence(__ATOMIC_ACQUIRE, "agent"); asm volatile("s_waitcnt vmcnt(0)" ::: "memory"); }
    else SEAM(PH_PREP);

    if (IN(PH_LOCAL)) {
        const int r = lane & 31, hl = lane >> 5;
        for (int task = gw; task < 8 * (M / 64); task += NGW) {
            const int cidx = task >> 3, h = task & 7; const size_t row0 = (size_t)cidx * 64;
            LAS float* LT = (LAS float*)(lds + wave * 16384);
            LAS float* tb = (LAS float*)(lds + TAB_OFF + wave * 512);
            tb[lane] = GG[(row0 + lane) * 8 + h]; tb[64 + lane] = BETA[(row0 + lane) * 8 + h];
            f32x16 kk00, kk01, kk11, qk00, qk01, qk11;
            {
                bf16x8 kf[2][8];
                const bf16* kbase = KR + (row0 + r) * GW + h * HD + 8 * hl; const bf16* qbase = QR + (row0 + r) * GW + h * HD + 8 * hl;
#pragma unroll
                for (int it = 0; it < 2; ++it)
#pragma unroll
                    for (int s = 0; s < 8; ++s) kf[it][s] = *(const bf16x8*)(kbase + (size_t)(32 * it) * GW + 16 * s);
#pragma unroll
                for (int e = 0; e < 16; ++e) { kk00[e] = 0.f; kk01[e] = 0.f; kk11[e] = 0.f; qk00[e] = 0.f; qk01[e] = 0.f; qk11[e] = 0.f; }
#pragma unroll
                for (int s = 0; s < 8; ++s) { kk00 = MFMA32(kf[0][s], kf[0][s], kk00); kk01 = MFMA32(kf[0][s], kf[1][s], kk01); kk11 = MFMA32(kf[1][s], kf[1][s], kk11); }
#pragma unroll
                for (int s = 0; s < 8; ++s) { const bf16x8 q0 = *(const bf16x8*)(qbase + 16 * s), q1 = *(const bf16x8*)(qbase + (size_t)32 * GW + 16 * s);
                    qk00 = MFMA32(kf[0][s], q0, qk00); qk01 = MFMA32(kf[0][s], q1, qk01); qk11 = MFMA32(kf[1][s], q1, qk11); }
            }
            LDS_WAIT(); asm volatile("" ::: "memory");
            const float gi0 = tb[r], gi1 = tb[32 + r], bi0 = tb[64 + r], bi1 = tb[96 + r];
            bf16* att = ATT + (size_t)task * 4096;
#pragma unroll
            for (int a = 0; a < 4; ++a) {
                const int j0 = 8 * a + 4 * hl; const f32x4 gj0 = *(const LAS f32x4*)(tb + j0), gj1 = *(const LAS f32x4*)(tb + 32 + j0);
                const int pj0 = (j0 & ~15) + perm16(j0 & 15);
                float l00[4], l01[4], l11[4], a00[4], a01[4], a11[4];
#pragma unroll
                for (int e = 0; e < 4; ++e) { const int j = j0 + e;
                    const float d00 = __expf(fminf(gi0 - gj0[e], 0.f)), d01 = __expf(fminf(gi1 - gj0[e], 0.f)), d11 = __expf(fminf(gi1 - gj1[e], 0.f));
                    l00[e] = (j < r) ? bi0 * kk00[4 * a + e] * d00 : 0.f; l01[e] = bi1 * kk01[4 * a + e] * d01; l11[e] = (j < r) ? bi1 * kk11[4 * a + e] * d11 : 0.f;
                    a00[e] = (j <= r) ? qk00[4 * a + e] * d00 : 0.f; a01[e] = qk01[4 * a + e] * d01; a11[e] = (j <= r) ? qk11[4 * a + e] * d11 : 0.f;
                    LT[(j) * 64 + r] = l00[e]; LT[(j) * 64 + 32 + r] = l01[e]; LT[(32 + j) * 64 + 32 + r] = l11[e]; LT[(32 + j) * 64 + r] = 0.f; }
                *(uint2*)(att + (size_t)r * 64 + pj0) = make_uint2(cvt2(a00[0], a00[1]), cvt2(a00[2], a00[3]));
                *(uint2*)(att + (size_t)r * 64 + 32 + pj0) = make_uint2(0u, 0u);
                *(uint2*)(att + (size_t)(32 + r) * 64 + pj0) = make_uint2(cvt2(a01[0], a01[1]), cvt2(a01[2], a01[3]));
                *(uint2*)(att + (size_t)(32 + r) * 64 + 32 + pj0) = make_uint2(cvt2(a11[0], a11[1]), cvt2(a11[2], a11[3]));
            }
            LDS_WAIT(); asm volatile("" ::: "memory");
            for (int j = 63; j >= 0; --j) {
                float acc = (lane == j) ? 1.0f : 0.f;
                for (int q = (j + 1) >> 2; q < 16; ++q) { const f32x4 lv = *(const LAS f32x4*)(LT + j * 64 + 4 * q);
                    const float t0 = LT[(4 * q + 0) * 64 + lane], t1 = LT[(4 * q + 1) * 64 + lane], t2 = LT[(4 * q + 2) * 64 + lane], t3 = LT[(4 * q + 3) * 64 + lane];
                    acc -= t0 * lv[0]; acc -= t1 * lv[1]; acc -= t2 * lv[2]; acc -= t3 * lv[3]; }
                LDS_WAIT(); asm volatile("" ::: "memory");
                LT[j * 64 + lane] = acc;
                LDS_WAIT(); asm volatile("" ::: "memory");
            }
            bf16* tm = TM + (size_t)task * 4096 + (size_t)lane * 64;
#pragma unroll
            for (int g = 0; g < 4; ++g) {
                float tr[16];
#pragma unroll
                for (int e = 0; e < 16; ++e) tr[e] = LT[(16 * g + e) * 64 + lane];
                *(v4u*)(tm + 16 * g) = (v4u){cvt2(tr[0], tr[1]), cvt2(tr[2], tr[3]), cvt2(tr[8], tr[9]), cvt2(tr[10], tr[11])};
                *(v4u*)(tm + 16 * g + 8) = (v4u){cvt2(tr[4], tr[5]), cvt2(tr[6], tr[7]), cvt2(tr[12], tr[13]), cvt2(tr[14], tr[15])}; }
            {
                tb[lane] = -tb[64 + lane] * __expf(tb[lane]);
                LDS_WAIT(); asm volatile("" ::: "memory");
                bf16x8 bfr[2][4];
#pragma unroll
                for (int it = 0; it < 2; ++it)
#pragma unroll
                    for (int s = 0; s < 4; ++s) { float v[8];
#pragma unroll
                        for (int jj = 0; jj < 8; ++jj) { const int tkn = 16 * s + perm16(8 * hl + jj); v[jj] = LT[tkn * 64 + 32 * it + r] * tb[tkn]; }
                        bfr[it][s] = __builtin_bit_cast(bf16x8, (v4u){cvt2(v[0], v[1]), cvt2(v[2], v[3]), cvt2(v[4], v[5]), cvt2(v[6], v[7])}); }
                const int bh = (cidx >> 6) * 8 + h, cs = cidx & 63;
#pragma unroll
                for (int dt = 0; dt < 4; ++dt) {
                    bf16x8 af[4];
#pragma unroll
                    for (int s = 0; s < 4; ++s) af[s] = *(const bf16x8*)(KT + (size_t)(bh * HD + 32 * dt + r) * SEQ + cs * 64 + 16 * s + 8 * hl);
                    f32x16 w0, w1;
#pragma unroll
                    for (int e = 0; e < 16; ++e) { w0[e] = 0.f; w1[e] = 0.f; }
#pragma unroll
                    for (int s = 0; s < 4; ++s) { w0 = MFMA32(af[s], bfr[0][s], w0); w1 = MFMA32(af[s], bfr[1][s], w1); }
#pragma unroll
                    for (int a = 0; a < 4; ++a) { const int d0 = 8 * a + 4 * hl; const int pd = 32 * dt + (d0 & ~15) + perm16(d0 & 15);
                        *(uint2*)(KR + (row0 + r) * GW + h * HD + pd) = make_uint2(cvt2(w0[4 * a], w0[4 * a + 1]), cvt2(w0[4 * a + 2], w0[4 * a + 3]));
                        *(uint2*)(KR + (row0 + 32 + r) * GW + h * HD + pd) = make_uint2(cvt2(w1[4 * a], w1[4 * a + 1]), cvt2(w1[4 * a + 2], w1[4 * a + 3])); }
                }
            }
            LDS_WAIT(); asm volatile("" ::: "memory");
        }
        for (int task = gw; task < 8 * (M / 64); task += NGW) {
            const int cidx = task >> 3, h = task & 7; const size_t row0 = (size_t)cidx * 64;
            bf16x8 kf[2][8];
            const bf16* kbase = PSLOT(5) + (row0 + r) * GW + h * HD + 8 * hl; const bf16* qbase = PSLOT(4) + (row0 + r) * GW + h * HD + 8 * hl;
#pragma unroll
            for (int it = 0; it < 2; ++it)
#pragma unroll
                for (int s = 0; s < 8; ++s) kf[it][s] = *(const bf16x8*)(kbase + (size_t)(32 * it) * GW + 16 * s);
            f32x16 t00, t01, t11;
#pragma unroll
            for (int e = 0; e < 16; ++e) { t00[e] = 0.f; t01[e] = 0.f; t11[e] = 0.f; }
#pragma unroll
            for (int s = 0; s < 8; ++s) { const bf16x8 q0 = *(const bf16x8*)(qbase + 16 * s), q1 = *(const bf16x8*)(qbase + (size_t)32 * GW + 16 * s);
                t00 = MFMA32(kf[0][s], q0, t00); t01 = MFMA32(kf[0][s], q1, t01); t11 = MFMA32(kf[1][s], q1, t11); }
            bf16* ha = HA + (size_t)task * 4096;
#pragma unroll
            for (int a = 0; a < 4; ++a) { const int j0 = 8 * a + 4 * hl; float v[4];
#pragma unroll
                for (int e = 0; e < 4; ++e) v[e] = (j0 + e <= r) ? t00[4 * a + e] : 0.f;
                *(uint2*)(ha + (size_t)r * 64 + j0) = make_uint2(cvt2(v[0], v[1]), cvt2(v[2], v[3]));
                *(uint2*)(ha + (size_t)r * 64 + 32 + j0) = make_uint2(0u, 0u);
                *(uint2*)(ha + (size_t)(32 + r) * 64 + j0) = make_uint2(cvt2(t01[4 * a], t01[4 * a + 1]), cvt2(t01[4 * a + 2], t01[4 * a + 3]));
#pragma unroll
                for (int e = 0; e < 4; ++e) v[e] = (j0 + e <= r) ? t11[4 * a + e] : 0.f;
                *(uint2*)(ha + (size_t)(32 + r) * 64 + 32 + j0) = make_uint2(cvt2(v[0], v[1]), cvt2(v[2], v[3])); }
        }
    }
    SEAM(PH_LOCAL);

    if (IN(PH_SCAN)) {
        if (bx >= 64) {
            LAS float* scr = (LAS float*)(lds + wave * 16384);
            constexpr int I_OUT = (D / 64) * (D / 32), I_1 = (D / 64) * (FF / 32), I_2 = (FF / 64) * (D / 32);
            for (int it = (bx - 64) * NWAVES + wave; it < I_OUT + I_1 + I_2; it += (G - 64) * NWAVES) {
                int q = it;
                if (q < I_OUT) { const int kb = q / (D / 32), nb = q % (D / 32); transpose_item(w_out, D, 32 * nb, 64 * kb, WOUT_T, D, 32 * nb, nullptr, scr, lane); continue; } q -= I_OUT;
                if (q < I_1) { const int kb = q / (FF / 32), nb = q % (FF / 32); transpose_item(w1, FF, 32 * nb, 64 * kb, W1_T, D, 32 * nb, w_ffn, scr, lane); continue; } q -= I_1;
                { const int kb = q / (D / 32), nb = q % (D / 32); transpose_item(w2, D, 32 * nb, 64 * kb, W2_T, FF, 32 * nb, nullptr, scr, lane); }
            }
        }
        constexpr int RS = 272, RH = 144, SBUF = 71680;
        const f32x16 Z16 = {0.f, 0.f, 0.f, 0.f, 0.f, 0.f, 0.f, 0.f, 0.f, 0.f, 0.f, 0.f, 0.f, 0.f, 0.f, 0.f};
#define SFRAG(dst, s_) do { const int bse_ = 8 * ((s_) & 1); v4u w_; w_.x = cvt2(S[(s_) >> 1][bse_ + 0], S[(s_) >> 1][bse_ + 1]); w_.y = cvt2(S[(s_) >> 1][bse_ + 2], S[(s_) >> 1][bse_ + 3]); \
        w_.z = cvt2(S[(s_) >> 1][bse_ + 4], S[(s_) >> 1][bse_ + 5]); w_.w = cvt2(S[(s_) >> 1][bse_ + 6], S[(s_) >> 1][bse_ + 7]); dst = __builtin_bit_cast(bf16x8, w_); } while (0)
#define TFRAG(dst, t0_, t1_, s_) do { const int bse_ = 8 * ((s_) & 1); v4u w_; \
        if ((s_) < 2) { w_.x = cvt2(t0_[bse_ + 0], t0_[bse_ + 1]); w_.y = cvt2(t0_[bse_ + 2], t0_[bse_ + 3]); w_.z = cvt2(t0_[bse_ + 4], t0_[bse_ + 5]); w_.w = cvt2(t0_[bse_ + 6], t0_[bse_ + 7]); } \
        else { w_.x = cvt2(t1_[bse_ + 0], t1_[bse_ + 1]); w_.y = cvt2(t1_[bse_ + 2], t1_[bse_ + 3]); w_.z = cvt2(t1_[bse_ + 4], t1_[bse_ + 5]); w_.w = cvt2(t1_[bse_ + 6], t1_[bse_ + 7]); } \
        dst = __builtin_bit_cast(bf16x8, w_); } while (0)
#define LDF(off_) (*(const LAS bf16x8*)(buf + (off_)))
        if (bx < 32) {
            const int bh = bx, b = bh >> 3, h = bh & 7; const size_t rowbase = (size_t)b * SEQ;
            constexpr int OK_ = 0, OQ_ = 64 * RS, OKT_ = 2 * 64 * RS, OTM_ = OKT_ + 128 * RH, OAT_ = OTM_ + 64 * RH;
            static_assert(OAT_ + 64 * RH == SBUF, "GDN chunk buffer");
            f32x16 S[4];
#pragma unroll
            for (int dt = 0; dt < 4; ++dt) S[dt] = Z16;
            f32x16 L0, L1, L2, L3; float lg = 0.f, lgl = 0.f, lb_ = 0.f;
            f32x16 P0, P1;
            const int n0 = 32 * (wave & 3); const int voff = (4 * (lane >> 5) * GW + (lane & 31)) * 4;
            const int fa = (lane & 31) * RS + (lane >> 5) * 16, fh = (lane & 31) * RH + (lane >> 5) * 16;
#define G_LOAD(cn_) do { int lt_ = tid - 256; asm volatile("" : "+v"(lt_)); const int task_ = ((b * 64 + (cn_)) << 3) + h; \
            _Pragma("unroll") for (int p = 0; p < 4; ++p) { const int idx = lt_ + 256 * p; const size_t o_ = (rowbase + (cn_) * 64 + (idx >> 4)) * GW + h * HD + 8 * (idx & 15); \
                { const v4u v_ = *(const v4u*)(KR + o_); L0[4 * p + 0] = __uint_as_float(v_.x); L0[4 * p + 1] = __uint_as_float(v_.y); L0[4 * p + 2] = __uint_as_float(v_.z); L0[4 * p + 3] = __uint_as_float(v_.w); } { const v4u v_ = *(const v4u*)(QR + o_); L1[4 * p + 0] = __uint_as_float(v_.x); L1[4 * p + 1] = __uint_as_float(v_.y); L1[4 * p + 2] = __uint_as_float(v_.z); L1[4 * p + 3] = __uint_as_float(v_.w); } { const v4u v_ = *(const v4u*)(KT + (size_t)(bh * HD + (idx >> 3)) * SEQ + (cn_) * 64 + 8 * (idx & 7)); L2[4 * p + 0] = __uint_as_float(v_.x); L2[4 * p + 1] = __uint_as_float(v_.y); L2[4 * p + 2] = __uint_as_float(v_.z); L2[4 * p + 3] = __uint_as_float(v_.w); } } \
            _Pragma("unroll") for (int p = 0; p < 2; ++p) { const int idx = lt_ + 256 * p; const size_t o_ = (size_t)task_ * 4096 + (idx >> 3) * 64 + 8 * (idx & 7); { const v4u v_ = *(const v4u*)(TM + o_); L3[4 * p + 0] = __uint_as_float(v_.x); L3[4 * p + 1] = __uint_as_float(v_.y); L3[4 * p + 2] = __uint_as_float(v_.z); L3[4 * p + 3] = __uint_as_float(v_.w); } { const v4u v_ = *(const v4u*)(ATT + o_); L3[8 + 4 * p + 0] = __uint_as_float(v_.x); L3[8 + 4 * p + 1] = __uint_as_float(v_.y); L3[8 + 4 * p + 2] = __uint_as_float(v_.z); L3[8 + 4 * p + 3] = __uint_as_float(v_.w); } } \
            if (lt_ < 64) { lg = GG[(rowbase + (cn_) * 64 + lt_) * 8 + h]; lgl = GG[(rowbase + (cn_) * 64 + 63) * 8 + h]; lb_ = BETA[(rowbase + (cn_) * 64 + lt_) * 8 + h]; } } while (0)
#define G_WRITE(cn_) do { int lt_ = tid - 256; asm volatile("" : "+v"(lt_)); LAS unsigned char* buf_ = lds + ((cn_) & 1) * SBUF; \
            _Pragma("unroll") for (int p = 0; p < 4; ++p) { const int idx = lt_ + 256 * p; { const int o_ = (idx >> 4) * RS + (idx & 15) * 16; *(LAS v4u*)(buf_ + OK_ + o_) = (v4u){__float_as_uint(L0[4 * p + 0]), __float_as_uint(L0[4 * p + 1]), __float_as_uint(L0[4 * p + 2]), __float_as_uint(L0[4 * p + 3])}; *(LAS v4u*)(buf_ + OQ_ + o_) = (v4u){__float_as_uint(L1[4 * p + 0]), __float_as_uint(L1[4 * p + 1]), __float_as_uint(L1[4 * p + 2]), __float_as_uint(L1[4 * p + 3])}; } \
                *(LAS v4u*)(buf_ + OKT_ + (idx >> 3) * RH + (idx & 7) * 16) = (v4u){__float_as_uint(L2[4 * p + 0]), __float_as_uint(L2[4 * p + 1]), __float_as_uint(L2[4 * p + 2]), __float_as_uint(L2[4 * p + 3])}; } \
            _Pragma("unroll") for (int p = 0; p < 2; ++p) { const int idx = lt_ + 256 * p; const int o_ = (idx >> 3) * RH + (idx & 7) * 16; *(LAS v4u*)(buf_ + OTM_ + o_) = (v4u){__float_as_uint(L3[4 * p + 0]), __float_as_uint(L3[4 * p + 1]), __float_as_uint(L3[4 * p + 2]), __float_as_uint(L3[4 * p + 3])}; *(LAS v4u*)(buf_ + OAT_ + o_) = (v4u){__float_as_uint(L3[8 + 4 * p + 0]), __float_as_uint(L3[8 + 4 * p + 1]), __float_as_uint(L3[8 + 4 * p + 2]), __float_as_uint(L3[8 + 4 * p + 3])}; } \
            if (lt_ < 64) { LAS float* tb_ = (LAS float*)(lds + TAB_OFF + ((cn_) & 1) * 1024); tb_[lt_] = lb_; tb_[64 + lt_] = __expf(lg); tb_[128 + lt_] = __expf(lgl - lg); } } while (0)
#define V_LOAD(cn_) do { const __amdgpu_buffer_rsrc_t vr_ = __builtin_amdgcn_make_buffer_rsrc(VF + (rowbase + (size_t)(cn_) * 64) * GW + h * HD + n0, 0, 64 * GW * 4, 0x00020000); \
            _Pragma("unroll") for (int e = 0; e < 16; ++e) { const int so = ((e & 3) + 8 * (e >> 2)) * GW * 4; \
                P0[e] = __uint_as_float(__builtin_amdgcn_raw_buffer_load_b32(vr_, voff, so, 0)); P1[e] = __uint_as_float(__builtin_amdgcn_raw_buffer_load_b32(vr_, voff, so + 32 * GW * 4, 0)); } } while (0)
            if (wave >= 4) {
                G_LOAD(0);
                for (int c = -1; c < SEQ / 64; ++c) {
                    if (c + 1 < SEQ / 64) { G_WRITE(c + 1); if (c + 2 < SEQ / 64) G_LOAD(c + 2); }
                    asm volatile("s_waitcnt lgkmcnt(0)" ::: "memory"); __builtin_amdgcn_s_barrier(); asm volatile("" ::: "memory");
                }
            } else {
                V_LOAD(0);
                asm volatile("s_waitcnt lgkmcnt(0)" ::: "memory"); __builtin_amdgcn_s_barrier(); asm volatile("" ::: "memory");
                for (int c = 0; c < SEQ / 64; ++c) {
                    const LAS unsigned char* buf = lds + (c & 1) * SBUF; const LAS float* tb = (const LAS float*)(lds + TAB_OFF + (c & 1) * 1024); const int hl = lane >> 5;
                    f32x16 p0, p1, o0, o1;
                    bf16x8 rf[4];
#pragma unroll
                    for (int a = 0; a < 4; ++a) { const int t4 = 8 * a + 4 * hl; const f32x4 b0 = *(const LAS f32x4*)(tb + t4), b1 = *(const LAS f32x4*)(tb + 32 + t4);
#pragma unroll
                        for (int e = 0; e < 4; ++e) { P0[4 * a + e] *= b0[e]; P1[4 * a + e] *= b1[e]; } }
#pragma unroll
                    for (int s = 0; s < 4; ++s) TFRAG(rf[s], P0, P1, s);
#pragma unroll
                    for (int s = 0; s < 4; ++s) { const bf16x8 t0 = LDF(OTM_ + fh + 32 * s), t1 = LDF(OTM_ + 32 * RH + fh + 32 * s); p0 = MFMA32(t0, rf[s], s == 0 ? Z16 : p0); p1 = MFMA32(t1, rf[s], s == 0 ? Z16 : p1); }
                    { const int cv = (c + 1 < SEQ / 64) ? c + 1 : c; V_LOAD(cv); }
                    bf16x8 sf[8];
#pragma unroll
                    for (int s = 0; s < 8; ++s) {
                        SFRAG(sf[s], s);
                        const bf16x8 k0 = LDF(OK_ + fa + 32 * s), k1 = LDF(OK_ + 32 * RS + fa + 32 * s);
                        p0 = MFMA32(k0, sf[s], p0); p1 = MFMA32(k1, sf[s], p1);
                    }
#pragma unroll
                    for (int s = 0; s < 8; ++s) {
                        const bf16x8 q0 = LDF(OQ_ + fa + 32 * s), q1 = LDF(OQ_ + 32 * RS + fa + 32 * s);
                        o0 = MFMA32(q0, sf[s], s == 0 ? Z16 : o0); o1 = MFMA32(q1, sf[s], s == 0 ? Z16 : o1);
                    }
#pragma unroll
                    for (int a = 0; a < 4; ++a) { const int t4 = 8 * a + 4 * hl; const f32x4 g0 = *(const LAS f32x4*)(tb + 64 + t4), g1 = *(const LAS f32x4*)(tb + 96 + t4);
#pragma unroll
                        for (int e = 0; e < 4; ++e) { o0[4 * a + e] *= g0[e]; o1[4 * a + e] *= g1[e]; } }
#pragma unroll
                    for (int s = 0; s < 4; ++s) TFRAG(rf[s], p0, p1, s);
#pragma unroll
                    for (int s = 0; s < 4; ++s) { const bf16x8 a0 = LDF(OAT_ + fh + 32 * s), a1 = LDF(OAT_ + 32 * RH + fh + 32 * s); o0 = MFMA32(a0, rf[s], o0); o1 = MFMA32(a1, rf[s], o1); }
#pragma unroll
                    for (int a = 0; a < 4; ++a) { const int t4 = 8 * a + 4 * hl; const f32x4 d0 = *(const LAS f32x4*)(tb + 128 + t4), d1 = *(const LAS f32x4*)(tb + 160 + t4);
#pragma unroll
                        for (int e = 0; e < 4; ++e) { p0[4 * a + e] *= d0[e]; p1[4 * a + e] *= d1[e]; } }
#pragma unroll
                    for (int s = 0; s < 4; ++s) TFRAG(rf[s], p0, p1, s);
                    const float sd = tb[64 + 63];
#pragma unroll
                    for (int dt = 0; dt < 4; ++dt) {
#pragma unroll
                        for (int e = 0; e < 16; ++e) S[dt][e] *= sd;
#pragma unroll
                        for (int s = 0; s < 4; ++s) S[dt] = MFMA32(LDF(OKT_ + 32 * dt * RH + fh + 32 * s), rf[s], S[dt]);
                    }
#pragma unroll
                    for (int hf = 0; hf < 2; ++hf) {
                        LAS unsigned char* ost = lds + OST_OFF + wave * 2048;
#pragma unroll
                        for (int e = 0; e < 16; ++e) *(LAS unsigned short*)(ost + ((e & 3) + 8 * (e >> 2) + 4 * hl) * 64 + 2 * (lane & 31)) = (unsigned short)(cvt2(hf ? o1[e] : o0[e], 0.f) & 0xffffu);
                        LDS_WAIT(); asm volatile("" ::: "memory");
                        const v4u w0 = *(const LAS v4u*)(ost + lane * 32), w1 = *(const LAS v4u*)(ost + lane * 32 + 16);
                        LDS_WAIT(); asm volatile("" ::: "memory");
                        bf16* op = OA + (rowbase + (size_t)c * 64 + 32 * hf + (lane >> 1)) * GW + h * HD + n0 + 16 * (lane & 1);
                        *(v4u*)op = w0; *(v4u*)(op + 8) = w1;
                    }
                    asm volatile("s_waitcnt lgkmcnt(0)" ::: "memory"); __builtin_amdgcn_s_barrier(); asm volatile("" ::: "memory");
                }
            }
#undef G_LOAD
#undef G_WRITE
#undef V_LOAD
        } else if (bx < 64) {
            const int bh = bx - 32, b = bh >> 3, h = bh & 7; const size_t rowbase = (size_t)b * SEQ;
            constexpr int OQ_ = 0, OKT_ = 64 * RS, OVT_ = OKT_ + 128 * RH, OA_ = OVT_ + 128 * RH;
            static_assert(OA_ + 64 * RH <= SBUF, "HGRN2 chunk buffer");
            LAS unsigned char* tab = lds + TAB_OFF;
            f32x16 S[4];
#pragma unroll
            for (int dt = 0; dt < 4; ++dt) S[dt] = Z16;
            f32x16 L0, L1, L2, L3;
            const int fa = (lane & 31) * RS + (lane >> 5) * 16, fh = (lane & 31) * RH + (lane >> 5) * 16;
#define H_LOAD(cn_) do { int lt_ = tid - 256; asm volatile("" : "+v"(lt_)); const int task_ = ((b * 64 + (cn_)) << 3) + h; \
            _Pragma("unroll") for (int p = 0; p < 4; ++p) { const int idx = lt_ + 256 * p; { const v4u v_ = *(const v4u*)(PSLOT(4) + (rowbase + (cn_) * 64 + (idx >> 4)) * GW + h * HD + 8 * (idx & 15)); L0[4 * p + 0] = __uint_as_float(v_.x); L0[4 * p + 1] = __uint_as_float(v_.y); L0[4 * p + 2] = __uint_as_float(v_.z); L0[4 * p + 3] = __uint_as_float(v_.w); } \
                { const v4u v_ = *(const v4u*)(HKT + (size_t)(bh * HD + (idx >> 3)) * SEQ + (cn_) * 64 + 8 * (idx & 7)); L1[4 * p + 0] = __uint_as_float(v_.x); L1[4 * p + 1] = __uint_as_float(v_.y); L1[4 * p + 2] = __uint_as_float(v_.z); L1[4 * p + 3] = __uint_as_float(v_.w); } { const v4u v_ = *(const v4u*)(HVT + (size_t)(bh * HD + (idx >> 3)) * SEQ + (cn_) * 64 + 8 * (idx & 7)); L2[4 * p + 0] = __uint_as_float(v_.x); L2[4 * p + 1] = __uint_as_float(v_.y); L2[4 * p + 2] = __uint_as_float(v_.z); L2[4 * p + 3] = __uint_as_float(v_.w); } } \
            _Pragma("unroll") for (int p = 0; p < 2; ++p) { const int idx = lt_ + 256 * p; { const v4u v_ = *(const v4u*)(HA + (size_t)task_ * 4096 + (idx >> 3) * 64 + 8 * (idx & 7)); L3[4 * p + 0] = __uint_as_float(v_.x); L3[4 * p + 1] = __uint_as_float(v_.y); L3[4 * p + 2] = __uint_as_float(v_.z); L3[4 * p + 3] = __uint_as_float(v_.w); } } \
            { const v4u v_ = *(const v4u*)(DTAB + (size_t)task_ * HD + 4 * (lt_ & 31)); L3[8 + 0] = __uint_as_float(v_.x); L3[8 + 1] = __uint_as_float(v_.y); L3[8 + 2] = __uint_as_float(v_.z); L3[8 + 3] = __uint_as_float(v_.w); } } while (0)
#define H_WRITE(cn_) do { int lt_ = tid - 256; asm volatile("" : "+v"(lt_)); LAS unsigned char* buf_ = lds + ((cn_) & 1) * SBUF; \
            _Pragma("unroll") for (int p = 0; p < 4; ++p) { const int idx = lt_ + 256 * p; *(LAS v4u*)(buf_ + OQ_ + (idx >> 4) * RS + (idx & 15) * 16) = (v4u){__float_as_uint(L0[4 * p + 0]), __float_as_uint(L0[4 * p + 1]), __float_as_uint(L0[4 * p + 2]), __float_as_uint(L0[4 * p + 3])}; \
                { const int o_ = (idx >> 3) * RH + (idx & 7) * 16; *(LAS v4u*)(buf_ + OKT_ + o_) = (v4u){__float_as_uint(L1[4 * p + 0]), __float_as_uint(L1[4 * p + 1]), __float_as_uint(L1[4 * p + 2]), __float_as_uint(L1[4 * p + 3])}; *(LAS v4u*)(buf_ + OVT_ + o_) = (v4u){__float_as_uint(L2[4 * p + 0]), __float_as_uint(L2[4 * p + 1]), __float_as_uint(L2[4 * p + 2]), __float_as_uint(L2[4 * p + 3])}; } } \
            _Pragma("unroll") for (int p = 0; p < 2; ++p) { const int idx = lt_ + 256 * p; *(LAS v4u*)(buf_ + OA_ + (idx >> 3) * RH + (idx & 7) * 16) = (v4u){__float_as_uint(L3[4 * p + 0]), __float_as_uint(L3[4 * p + 1]), __float_as_uint(L3[4 * p + 2]), __float_as_uint(L3[4 * p + 3])}; } \
            if (lt_ < 32) *(LAS v4u*)(tab + ((cn_) & 1) * 512 + 16 * lt_) = (v4u){__float_as_uint(L3[8 + 0]), __float_as_uint(L3[8 + 1]), __float_as_uint(L3[8 + 2]), __float_as_uint(L3[8 + 3])}; } while (0)
            if (wave >= 4) {
                H_LOAD(0);
                for (int c = -1; c < SEQ / 64; ++c) {
                    if (c + 1 < SEQ / 64) { H_WRITE(c + 1); if (c + 2 < SEQ / 64) H_LOAD(c + 2); }
                    asm volatile("s_waitcnt lgkmcnt(0)" ::: "memory"); __builtin_amdgcn_s_barrier(); asm volatile("" ::: "memory");
                }
            } else {
                asm volatile("s_waitcnt lgkmcnt(0)" ::: "memory"); __builtin_amdgcn_s_barrier(); asm volatile("" ::: "memory");
                for (int c = 0; c < SEQ / 64; ++c) {
                    const LAS unsigned char* buf = lds + (c & 1) * SBUF; const int n0 = 32 * wave, hl = lane >> 5;
                    f32x16 o0, o1;
#pragma unroll
                    for (int s = 0; s < 8; ++s) { bf16x8 sf; SFRAG(sf, s); const bf16x8 q0 = LDF(OQ_ + fa + 32 * s), q1 = LDF(OQ_ + 32 * RS + fa + 32 * s); o0 = MFMA32(q0, sf, s == 0 ? Z16 : o0); o1 = MFMA32(q1, sf, s == 0 ? Z16 : o1); }
                    bf16x8 vf[4];
#pragma unroll
                    for (int s = 0; s < 4; ++s) vf[s] = LDF(OVT_ + n0 * RH + fh + 32 * s);
#pragma unroll
                    for (int s = 0; s < 4; ++s) { const bf16x8 a0 = LDF(OA_ + fh + 32 * s), a1 = LDF(OA_ + 32 * RH + fh + 32 * s); o0 = MFMA32(a0, vf[s], o0); o1 = MFMA32(a1, vf[s], o1); }
#pragma unroll
                    for (int dt = 0; dt < 4; ++dt) {
#pragma unroll
                        for (int s = 0; s < 4; ++s) S[dt] = MFMA32(LDF(OKT_ + 32 * dt * RH + fh + 32 * s), vf[s], S[dt]);
#pragma unroll
                        for (int a = 0; a < 4; ++a) { const f32x4 dv = *(const LAS f32x4*)(tab + (c & 1) * 512 + (32 * dt + 8 * a + 4 * hl) * 4);
#pragma unroll
                            for (int e = 0; e < 4; ++e) S[dt][4 * a + e] *= dv[e]; }
                    }
#pragma unroll
                    for (int hf = 0; hf < 2; ++hf) {
                        LAS unsigned char* ost = lds + OST_OFF + wave * 2048;
#pragma unroll
                        for (int e = 0; e < 16; ++e) *(LAS unsigned short*)(ost + ((e & 3) + 8 * (e >> 2) + 4 * hl) * 64 + 2 * (lane & 31)) = (unsigned short)(cvt2(hf ? o1[e] : o0[e], 0.f) & 0xffffu);
                        LDS_WAIT(); asm volatile("" ::: "memory");
                        const v4u w0 = *(const LAS v4u*)(ost + lane * 32), w1 = *(const LAS v4u*)(ost + lane * 32 + 16);
                        LDS_WAIT(); asm volatile("" ::: "memory");
                        bf16* op = OBH + (rowbase + (size_t)c * 64 + 32 * hf + (lane >> 1)) * GW + h * HD + n0 + 16 * (lane & 1);
                        *(v4u*)op = w0; *(v4u*)(op + 8) = w1;
                    }
                    asm volatile("s_waitcnt lgkmcnt(0)" ::: "memory"); __builtin_amdgcn_s_barrier(); asm volatile("" ::: "memory");
                }
            }
#undef H_LOAD
#undef H_WRITE
        }
#undef SFRAG
#undef TFRAG
#undef LDF
    }
    SEAM(PH_SCAN);

    if (IN(PH_GNORM)) {
        f32x2 nwa, nwb; nwa = *(const f32x2*)(gdn_nw + 2 * lane); nwb = *(const f32x2*)(hgrn_nw + 2 * lane);
        for (int m = gw * 8; m < M; m += NGW * 8) {
#pragma unroll 1
            for (int mi = 0; mi < 8; ++mi) {
                const size_t off = (size_t)(m + mi) * GW + 2 * lane;
                f32x2 o[16]; unsigned gu[16];
#pragma unroll
                for (int hs = 0; hs < 16; ++hs) { const int h = hs & 7; const unsigned ou = *(const unsigned*)((hs >= 8 ? OBH : OA) + off + h * HD); o[hs] = (f32x2){bf_lo(ou), bf_hi(ou)}; gu[hs] = *(const unsigned*)((hs >= 8 ? PSLOT(7) : PSLOT(3)) + off + h * HD); }
#pragma unroll
                for (int hs = 0; hs < 16; ++hs) {
                    const float ms = wave_sum(o[hs][0] * o[hs][0] + o[hs][1] * o[hs][1]) * (1.0f / HD); const float r = __builtin_amdgcn_rsqf(ms + NORM_EPS);
                    const f32x2 nw = hs >= 8 ? nwb : nwa;
                    *(unsigned*)(Y + (size_t)(m + mi) * D + hs * HD + 2 * lane) = cvt2(o[hs][0] * r * nw[0] * siluf_(bf_lo(gu[hs])), o[hs][1] * r * nw[1] * siluf_(bf_hi(gu[hs])));
                }
            }
        }
    }
    SEAM(PH_GNORM);

    if (IN(PH_G2)) {
        pg8::Gemm g{Y, WOUT_T, M, D, D}; pg8::StaticOrder S; S.init(M, D, G, bx);
        pg8::EpiResidToBf E{x, HB, SS1, D};
        pg8::gemm_phase<pg8::EpiResidToBf, pg8::StaticOrder, true, true>(lds, g, S, E);
    }
    SEAM(PH_G2);

    if (IN(PH_G3)) {
        pg8::Gemm g{HB, W1_T, M, FF, D}; pg8::StaticOrder S; S.init(M, FF, G, bx);
        pg8::EpiAct E{ACT, FF, SS1, 1.0f / D, NORM_EPS};
        pg8::gemm_phase<pg8::EpiAct, pg8::StaticOrder, true, true>(lds, g, S, E);
    }
    SEAM(PH_G3);

    if (IN(PH_G4)) {
        pg8::Gemm g{ACT, W2_T, M, D, FF}; pg8::StaticOrder S; S.init(M, D, G, bx);
        pg8::EpiResidFromBf E{HB, SS2, D};
        pg8::gemm_phase<pg8::EpiResidFromBf, pg8::StaticOrder, true, true>(lds, g, S, E);
    }
    SEAM(PH_G4);

    if (IN(PH_FIN)) {
        for (int m = gw * 2; m < M; m += NGW * 2) {
            const float pa = (lane < 32) ? SS2[(size_t)m * 32 + lane] : 0.f, pb = (lane < 32) ? SS2[(size_t)(m + 1) * 32 + lane] : 0.f;
            v4u ha[4], hb4[4];
#pragma unroll
            for (int j = 0; j < 4; ++j) { ha[j] = *(const v4u*)(HB + (size_t)m * D + 512 * j + 8 * lane); hb4[j] = *(const v4u*)(HB + (size_t)(m + 1) * D + 512 * j + 8 * lane); }
            const float ra = __builtin_amdgcn_rsqf(wave_sum(pa) * (1.0f / D) + NORM_EPS), rb = __builtin_amdgcn_rsqf(wave_sum(pb) * (1.0f / D) + NORM_EPS);
#pragma unroll
            for (int j = 0; j < 4; ++j) {
                const f32x4 w0 = *(const f32x4*)(w_fin + 512 * j + 8 * lane), w1 = *(const f32x4*)(w_fin + 512 * j + 8 * lane + 4);
                f32x4* oa = (f32x4*)(out + (size_t)m * D + 512 * j + 8 * lane); f32x4* ob = (f32x4*)(out + (size_t)(m + 1) * D + 512 * j + 8 * lane);
                oa[0] = (f32x4){bf_lo(ha[j].x), bf_hi(ha[j].x), bf_lo(ha[j].y), bf_hi(ha[j].y)} * ra * w0; oa[1] = (f32x4){bf_lo(ha[j].z), bf_hi(ha[j].z), bf_lo(ha[j].w), bf_hi(ha[j].w)} * ra * w1;
                ob[0] = (f32x4){bf_lo(hb4[j].x), bf_hi(hb4[j].x), bf_lo(hb4[j].y), bf_hi(hb4[j].y)} * rb * w0; ob[1] = (f32x4){bf_lo(hb4[j].z), bf_hi(hb4[j].z), bf_lo(hb4[j].w), bf_hi(hb4[j].w)} * rb * w1;
            }
        }
    }
#undef IN
#undef SEAM
#undef PSLOT
}

extern "C" void kernel_launch(void* const* d_in, const int* in_sizes, int n_in, void* d_out, int out_size, void* d_ws, size_t ws_size, hipStream_t stream) {
    static int grid = 0;
    if (grid == 0) {
        if (n_in != 14 || in_sizes[0] != M * D || out_size != M * D || ws_size < WS_END) { fprintf(stderr, "kernel_launch: shape/workspace mismatch (n_in %d, in0 %d, out %d, ws %zu)\n", n_in, n_in > 0 ? in_sizes[0] : -1, out_size, ws_size); grid = -1; return; }
        int dev = 0, cus = 0, per_cu = 0;
        if (hipGetDevice(&dev) != hipSuccess || hipDeviceGetAttribute(&cus, hipDeviceAttributeMultiprocessorCount, dev) != hipSuccess) { grid = -1; return; }
        if (hipFuncSetAttribute((const void*)hyb_fwd, hipFuncAttributeMaxDynamicSharedMemorySize, LDS_BYTES) != hipSuccess) { fprintf(stderr, "kernel_launch: hipFuncSetAttribute failed\n"); grid = -1; return; }
        if (hipOccupancyMaxActiveBlocksPerMultiprocessor(&per_cu, (const void*)hyb_fwd, NTHREADS, LDS_BYTES) != hipSuccess || per_cu < 1) { fprintf(stderr, "kernel_launch: occupancy query says %d blocks per CU\n", per_cu); grid = -1; (void)hipGetLastError(); return; }
        grid = cus;
    }
    if (grid < 0) return;
    if (hipMemsetAsync((char*)d_ws + WS_CTL, 0, CTL_ZERO_BYTES, stream) != hipSuccess) return;
    Args a{};
    for (int i = 0; i < 14; ++i) a.in[i] = (const float*)d_in[i];
    a.out = (float*)d_out; a.ws = (unsigned char*)d_ws;
    for (int li = 0; li < N_LAUNCHES; ++li) {
        a.ph_lo = (N_LAUNCHES == 1) ? 0 : li; a.ph_hi = (N_LAUNCHES == 1) ? N_PHASES : li + 1; a.li = li;
        hipLaunchKernelGGL(hyb_fwd, dim3(grid), dim3(NTHREADS), LDS_BYTES, stream, a);
        const hipError_t le = hipPeekAtLastError();
        if (le != hipSuccess) { fprintf(stderr, "kernel_launch: launch %d failed: %s\n", li, hipGetErrorName(le)); break; }
    }
}
```

```cpp
#include <hip/hip_runtime.h>
#include <cstdio>
#include <cstdint>
namespace pg8 {
#define PG8_LAS __attribute__((address_space(3)))
typedef unsigned short bf16_t;
typedef short bf16x8 __attribute__((ext_vector_type(8)));
typedef float f32x4 __attribute__((ext_vector_type(4)));
typedef unsigned u32x4 __attribute__((ext_vector_type(4)));
constexpr int BM = 256, BK = 64, HALF = 128, HTB = HALF * BK * 2  , STAGE_BYTES = 8 * HTB, NXCD = 8, WGM = 8;

__host__ __device__ __forceinline__ int lds_byte(int r, int c) { const int st = (r >> 4) * 2 + (c >> 5), rr = r & 15, cc = c & 31, ob = rr * 64 + cc * 2; return st * 1024 + (ob ^ (((ob >> 9) & 1) << 5)); }
__host__ __device__ __forceinline__ void stage_rc(int b, int& R, int& C) { const int st = b / 1024, sb = b % 1024, swz = sb ^ (((sb >> 9) & 1) << 5); R = (st >> 1) * 16 + swz / 64; C = (st & 1) * 32 + (swz % 64) / 2; }
__host__ __device__ __forceinline__ int perm32(int rho) { const int n = rho >> 4, i = rho & 15; return 8 * (i >> 2) + 4 * n + (i & 3); }

struct Unit { int pm, pn; };
struct Gemm { const bf16_t* A; const bf16_t* Bt; int M, N, K; };

struct StaticOrder {
    int nM, nN, nwg, G, c;
    __host__ __device__ void init(int M, int N, int G_, int c_) { nM = M / BM; nN = N / BM; nwg = nM * nN; G = G_; c = c_; }
    __host__ __device__ bool next(int i, Unit& u) const {
        const long L = (long)i * G + c; if (L >= nwg) return false;
        int wgid = (int)L; { const int q = nwg / NXCD, r = nwg % NXCD, xcd = wgid % NXCD, off = wgid / NXCD; wgid = (xcd < r ? xcd * (q + 1) : r * (q + 1) + (xcd - r) * q) + off; }
        const int nig = WGM * nN, gid = wgid / nig, fm = gid * WGM, gsz = (nM - fm) < WGM ? (nM - fm) : WGM;
        u.pm = fm + ((wgid % nig) % gsz); u.pn = (wgid % nig) / gsz; return true;
    }
    __device__ __forceinline__ void a_ready(const Unit&) const {}
    __device__ __forceinline__ void done(const Unit&) const {}
};

__device__ __forceinline__ unsigned cvt_pk_bf16(float lo, float hi) { unsigned r; asm volatile("v_cvt_pk_bf16_f32 %0, %1, %2" : "=v"(r) : "v"(lo), "v"(hi)); return r; }
typedef float f32x2 __attribute__((ext_vector_type(2)));
struct EpiBf16Split {
    static constexpr bool PERM = true, AFTER_DRAIN = false;
    bf16_t* O; int ldc; int split_cols; size_t split_stride;
    __device__ __forceinline__ void operator()(const f32x4 (&acc)[2][2][4][2], const Unit& u, int wr, int wc, int fr, int fq) const {
        const int row0 = u.pm * BM + wr * 64 + fr; int colt = u.pn * BM; bf16_t* base = O;
        { const int t = colt / split_cols; base += (size_t)t * split_stride; colt -= t * split_cols; }
        const int col0 = colt + wc * 32 + 8 * fq;
#pragma unroll
        for (int ai = 0; ai < 2; ++ai)
#pragma unroll
            for (int m = 0; m < 4; ++m) { bf16_t* rowp = base + (size_t)(row0 + ai * HALF + m * 16) * ldc + col0;
#pragma unroll
                for (int bj = 0; bj < 2; ++bj) { const f32x4 v0 = acc[ai][bj][m][0], v1 = acc[ai][bj][m][1];
                    u32x4 w; w.x = cvt_pk_bf16(v0[0], v0[1]); w.y = cvt_pk_bf16(v0[2], v0[3]); w.z = cvt_pk_bf16(v1[0], v1[1]); w.w = cvt_pk_bf16(v1[2], v1[3]);
                    *(u32x4*)(rowp + bj * HALF) = w; } }
    }
};
template <bool WRITE_BF16> struct EpiResid {
    static constexpr bool PERM = true, AFTER_DRAIN = false;
    const float* base; float* out; bf16_t* hb; float* ss; int ldc;
    __device__ __forceinline__ void operator()(const f32x4 (&acc)[2][2][4][2], const Unit& u, int wr, int wc, int fr, int fq) const {
        const int row0 = u.pm * BM + wr * 64 + fr, col0 = u.pn * BM + wc * 32 + 8 * fq;
#pragma unroll
        for (int ai = 0; ai < 2; ++ai)
#pragma unroll
            for (int m = 0; m < 4; ++m) { const int row = row0 + ai * HALF + m * 16; const size_t off = (size_t)row * ldc + col0; float sq = 0.f;
#pragma unroll
                for (int bj = 0; bj < 2; ++bj) {
                    const f32x4 b0 = *(const f32x4*)(base + off + bj * HALF), b1 = *(const f32x4*)(base + off + bj * HALF + 4);
                    const f32x4 v0 = acc[ai][bj][m][0] + b0, v1 = acc[ai][bj][m][1] + b1;
                    sq += (v0[0] * v0[0] + v0[1] * v0[1]) + (v0[2] * v0[2] + v0[3] * v0[3]) + (v1[0] * v1[0] + v1[1] * v1[1]) + (v1[2] * v1[2] + v1[3] * v1[3]);
                    *(f32x4*)(out + off + bj * HALF) = v0; *(f32x4*)(out + off + bj * HALF + 4) = v1;
                    if (WRITE_BF16) { u32x4 w; w.x = cvt_pk_bf16(v0[0], v0[1]); w.y = cvt_pk_bf16(v0[2], v0[3]); w.z = cvt_pk_bf16(v1[0], v1[1]); w.w = cvt_pk_bf16(v1[2], v1[3]);
                        *(u32x4*)(hb + off + bj * HALF) = w; } }
                sq += __shfl_xor(sq, 16); sq += __shfl_xor(sq, 32);
                if (fq == 0) ss[(size_t)row * 32 + u.pn * 4 + wc] = sq;
                if (m & 1) asm volatile("" ::: "memory"); }
    }
};
struct EpiResidToBf {
    static constexpr bool PERM = true, AFTER_DRAIN = false;
    const float* base; bf16_t* hb; float* ss; int ldc;
    __device__ __forceinline__ void operator()(const f32x4 (&acc)[2][2][4][2], const Unit& u, int wr, int wc, int fr, int fq) const {
        const int row0 = u.pm * BM + wr * 64 + fr, col0 = u.pn * BM + wc * 32 + 8 * fq;
#pragma unroll
        for (int ai = 0; ai < 2; ++ai)
#pragma unroll
            for (int m = 0; m < 4; ++m) { const int row = row0 + ai * HALF + m * 16; const size_t off = (size_t)row * ldc + col0; float sq = 0.f;
#pragma unroll
                for (int bj = 0; bj < 2; ++bj) {
                    const f32x4 b0 = *(const f32x4*)(base + off + bj * HALF), b1 = *(const f32x4*)(base + off + bj * HALF + 4);
                    const f32x4 v0 = acc[ai][bj][m][0] + b0, v1 = acc[ai][bj][m][1] + b1;
                    sq += (v0[0] * v0[0] + v0[1] * v0[1]) + (v0[2] * v0[2] + v0[3] * v0[3]) + (v1[0] * v1[0] + v1[1] * v1[1]) + (v1[2] * v1[2] + v1[3] * v1[3]);
                    u32x4 w; w.x = cvt_pk_bf16(v0[0], v0[1]); w.y = cvt_pk_bf16(v0[2], v0[3]); w.z = cvt_pk_bf16(v1[0], v1[1]); w.w = cvt_pk_bf16(v1[2], v1[3]);
                    *(u32x4*)(hb + off + bj * HALF) = w; }
                sq += __shfl_xor(sq, 16); sq += __shfl_xor(sq, 32);
                if (fq == 0) ss[(size_t)row * 32 + u.pn * 4 + wc] = sq;
                if (m & 1) asm volatile("" ::: "memory"); }
    }
};
struct EpiResidFromBf {
    static constexpr bool PERM = true, AFTER_DRAIN = false;
    bf16_t* hb; float* ss; int ldc;
    __device__ __forceinline__ void operator()(const f32x4 (&acc)[2][2][4][2], const Unit& u, int wr, int wc, int fr, int fq) const {
        const int row0 = u.pm * BM + wr * 64 + fr, col0 = u.pn * BM + wc * 32 + 8 * fq;
#pragma unroll
        for (int ai = 0; ai < 2; ++ai)
#pragma unroll
            for (int m = 0; m < 4; ++m) { const int row = row0 + ai * HALF + m * 16; const size_t off = (size_t)row * ldc + col0; float sq = 0.f;
#pragma unroll
                for (int bj = 0; bj < 2; ++bj) {
                    const u32x4 hw = *(const u32x4*)(hb + off + bj * HALF);
                    const f32x4 b0 = {__uint_as_float(hw.x << 16), __uint_as_float(hw.x & 0xffff0000u), __uint_as_float(hw.y << 16), __uint_as_float(hw.y & 0xffff0000u)};
                    const f32x4 b1 = {__uint_as_float(hw.z << 16), __uint_as_float(hw.z & 0xffff0000u), __uint_as_float(hw.w << 16), __uint_as_float(hw.w & 0xffff0000u)};
                    const f32x4 v0 = acc[ai][bj][m][0] + b0, v1 = acc[ai][bj][m][1] + b1;
                    sq += (v0[0] * v0[0] + v0[1] * v0[1]) + (v0[2] * v0[2] + v0[3] * v0[3]) + (v1[0] * v1[0] + v1[1] * v1[1]) + (v1[2] * v1[2] + v1[3] * v1[3]);
                    u32x4 w; w.x = cvt_pk_bf16(v0[0], v0[1]); w.y = cvt_pk_bf16(v0[2], v0[3]); w.z = cvt_pk_bf16(v1[0], v1[1]); w.w = cvt_pk_bf16(v1[2], v1[3]);
                    *(u32x4*)(hb + off + bj * HALF) = w; }
                sq += __shfl_xor(sq, 16); sq += __shfl_xor(sq, 32);
                if (fq == 0) ss[(size_t)row * 32 + u.pn * 4 + wc] = sq;
                if (m & 1) asm volatile("" ::: "memory"); }
    }
};
struct EpiAct {
    static constexpr bool PERM = true, AFTER_DRAIN = false;
    bf16_t* O; int ldc; const float* ss; float inv_n, eps;
    __device__ __forceinline__ void operator()(const f32x4 (&acc)[2][2][4][2], const Unit& u, int wr, int wc, int fr, int fq) const {
        const int row0 = u.pm * BM + wr * 64 + fr, col0 = u.pn * BM + wc * 32 + 8 * fq;
#pragma unroll
        for (int ai = 0; ai < 2; ++ai)
#pragma unroll
            for (int m = 0; m < 4; ++m) { const int row = row0 + ai * HALF + m * 16;
                const f32x4 p0 = *(const f32x4*)(ss + (size_t)row * 32 + 8 * fq), p1 = *(const f32x4*)(ss + (size_t)row * 32 + 8 * fq + 4);
                float s = ((p0[0] + p0[1]) + (p0[2] + p0[3])) + ((p1[0] + p1[1]) + (p1[2] + p1[3]));
                s += __shfl_xor(s, 16); s += __shfl_xor(s, 32);
                const float r2 = 1.0f / (s * inv_n + eps);
                bf16_t* rowp = O + (size_t)row * ldc + col0;
#pragma unroll
                for (int bj = 0; bj < 2; ++bj) { f32x4 v0 = acc[ai][bj][m][0], v1 = acc[ai][bj][m][1];
#pragma unroll
                    for (int e = 0; e < 4; ++e) { const float a = fmaxf(v0[e], 0.f), b = fmaxf(v1[e], 0.f); v0[e] = a * a * r2; v1[e] = b * b * r2; }
                    u32x4 w; w.x = cvt_pk_bf16(v0[0], v0[1]); w.y = cvt_pk_bf16(v0[2], v0[3]); w.z = cvt_pk_bf16(v1[0], v1[1]); w.w = cvt_pk_bf16(v1[2], v1[3]);
                    *(u32x4*)(rowp + bj * HALF) = w; } }
    }
};

template <class Epi, class Sched, bool ALIGN_EPI = false, bool SP2 = false>
__device__ __forceinline__ void gemm_phase(PG8_LAS unsigned char* lds, const Gemm g, const Sched& S, const Epi& E) {
    const int tid = threadIdx.x, wid = __builtin_amdgcn_readfirstlane(tid >> 6), lane = tid & 63, wr = wid >> 2, wc = wid & 3, fr = lane & 15, fq = lane >> 4;
    const int K = g.K, nt = K / BK;
    unsigned voffA[2], voffB[2];
#pragma unroll
    for (int i = 0; i < 2; ++i) { int R, C; stage_rc(tid * 16 + i * 8192, R, C); const int Rb = Epi::PERM ? ((R & ~31) + perm32(R & 31)) : R;
        voffA[i] = (unsigned)(R * K + C) * 2u; voffB[i] = (unsigned)(Rb * K + C) * 2u; }
    const size_t kstep = (size_t)(BK * 2);
    const size_t hstep = (size_t)HALF * K * 2;
    const size_t tstep = 2 * hstep;
    const unsigned ldsw = (unsigned)wid * 1024u;
    const int aoff = lds_byte(wr * 64 + fr, fq * 8), boff = lds_byte(wc * 32 + fr, fq * 8);
#define PG8_SA(b, h) (((b) * 2 + (h)) * HTB)
#define PG8_SB(b, h) ((4 + (b) * 2 + (h)) * HTB)
#define PG8_STAGE(bufoff, gbase, voff) do { _Pragma("unroll") for (int _i = 0; _i < 2; ++_i) \
        __builtin_amdgcn_global_load_lds((const unsigned*)((const char*)(gbase) + (voff)[_i]), (PG8_LAS unsigned*)(lds + (bufoff) + ldsw + _i * 8192), 16, 0, 0); } while (0)
#define PG8_LDA(dst, b, h) do { _Pragma("unroll") for (int m = 0; m < 4; ++m) _Pragma("unroll") for (int k = 0; k < 2; ++k) dst[m][k] = *(const PG8_LAS bf16x8*)(lds + PG8_SA(b, h) + aoff + m * 2048 + k * 1024); } while (0)
#define PG8_LDB(dst, b, h) do { _Pragma("unroll") for (int n = 0; n < 2; ++n) _Pragma("unroll") for (int k = 0; k < 2; ++k) dst[n][k] = *(const PG8_LAS bf16x8*)(lds + PG8_SB(b, h) + boff + n * 2048 + k * 1024); } while (0)
#define PG8_MMA(ai, bj, At, Bt) do { __builtin_amdgcn_s_setprio(1); _Pragma("unroll") for (int m = 0; m < 4; ++m) _Pragma("unroll") for (int n = 0; n < 2; ++n) _Pragma("unroll") for (int k = 0; k < 2; ++k) \
        acc[ai][bj][m][n] = __builtin_amdgcn_mfma_f32_16x16x32_bf16(Bt[n][k], At[m][k], acc[ai][bj][m][n], 0, 0, 0); __builtin_amdgcn_s_setprio(0); } while (0)
#define PG8_WAIT_V(n) asm volatile("s_waitcnt vmcnt(" #n ")" ::: "memory")
#define PG8_WAIT_L(n) asm volatile("s_waitcnt lgkmcnt(" #n ")" ::: "memory")
#define PG8_BAR __builtin_amdgcn_s_barrier()
#define PG8_SCHED __builtin_amdgcn_sched_barrier(0)
    Unit cur, nxt; int ui = 0;
    if (!S.next(0, cur)) return;
    f32x4 acc[2][2][4][2];
#pragma unroll
    for (int a = 0; a < 2; ++a)
#pragma unroll
        for (int b = 0; b < 2; ++b)
#pragma unroll
            for (int m = 0; m < 4; ++m)
#pragma unroll
                for (int n = 0; n < 2; ++n) acc[a][b][m][n] = (f32x4){0.f, 0.f, 0.f, 0.f};
    bf16x8 At[4][2], B0[2][2], B1[2][2];
    const char* cA = (const char*)g.A + (size_t)cur.pm * tstep; const char* cB = (const char*)g.Bt + (size_t)cur.pn * tstep;
    S.a_ready(cur);
    if constexpr (SP2) {
        PG8_STAGE(PG8_SB(0, 0), cB, voffB); PG8_STAGE(PG8_SB(0, 1), cB + hstep, voffB); PG8_STAGE(PG8_SA(0, 0), cA, voffA); PG8_STAGE(PG8_SA(0, 1), cA + hstep, voffA);
        if (wr == 1) PG8_BAR;
        PG8_WAIT_V(2); PG8_BAR;
        PG8_STAGE(PG8_SB(1, 0), cB + kstep, voffB); PG8_STAGE(PG8_SA(1, 0), cA + kstep, voffA); PG8_STAGE(PG8_SB(1, 1), cB + hstep + kstep, voffB);
        PG8_WAIT_V(6); PG8_BAR;
    } else {
        PG8_STAGE(PG8_SB(0, 0), cB, voffB); PG8_STAGE(PG8_SA(0, 0), cA, voffA); PG8_STAGE(PG8_SB(0, 1), cB + hstep, voffB); PG8_STAGE(PG8_SA(0, 1), cA + hstep, voffA);
        if (wr == 1) PG8_BAR;
        PG8_WAIT_V(4); PG8_BAR;
        PG8_STAGE(PG8_SB(1, 0), cB + kstep, voffB); PG8_STAGE(PG8_SA(1, 0), cA + kstep, voffA); PG8_STAGE(PG8_SB(1, 1), cB + hstep + kstep, voffB);
        PG8_WAIT_V(6); PG8_BAR;
    }
    for (;;) {
        const bool has_next = S.next(ui + 1, nxt);
        const char* nA = has_next ? (const char*)g.A + (size_t)nxt.pm * tstep : cA; const char* nB = has_next ? (const char*)g.Bt + (size_t)nxt.pn * tstep : cB;
        for (int t = 0; t < nt; t += 2) {
            const bool last = (t == nt - 2);
            const char* a1 = cA + (size_t)(t + 1) * kstep;
            const char* a2 = last ? nA : cA + (size_t)(t + 2) * kstep; const char* b2 = last ? nB : cB + (size_t)(t + 2) * kstep;
            const char* a3 = a2 + kstep; const char* b3 = b2 + kstep;
            if (last && has_next) S.a_ready(nxt);
            if constexpr (SP2) {
            PG8_LDB(B0, 0, 0); PG8_LDB(B1, 0, 1); PG8_SCHED; PG8_LDA(At, 0, 0); PG8_STAGE(PG8_SA(1, 1), a1 + hstep, voffA);
            PG8_WAIT_V(8); PG8_WAIT_L(0); PG8_BAR; PG8_MMA(0, 0, At, B0); PG8_MMA(0, 1, At, B1); PG8_BAR; PG8_SCHED;
            PG8_LDA(At, 0, 1); PG8_STAGE(PG8_SB(0, 0), b2, voffB); PG8_STAGE(PG8_SB(0, 1), b2 + hstep, voffB); PG8_STAGE(PG8_SA(0, 0), a2, voffA);
            PG8_WAIT_V(8); PG8_WAIT_L(0); PG8_BAR; PG8_MMA(1, 0, At, B0); PG8_MMA(1, 1, At, B1); PG8_BAR; PG8_SCHED;
            PG8_LDB(B0, 1, 0); PG8_LDB(B1, 1, 1); PG8_SCHED; PG8_LDA(At, 1, 0); PG8_STAGE(PG8_SA(0, 1), a2 + hstep, voffA);
            PG8_WAIT_V(8); PG8_WAIT_L(0); PG8_BAR; PG8_MMA(0, 0, At, B0); PG8_MMA(0, 1, At, B1); PG8_BAR; PG8_SCHED;
            PG8_LDA(At, 1, 1); PG8_STAGE(PG8_SB(1, 0), b3, voffB); PG8_STAGE(PG8_SB(1, 1), b3 + hstep, voffB); PG8_STAGE(PG8_SA(1, 0), a3, voffA);
            PG8_WAIT_V(8); PG8_WAIT_L(0); PG8_BAR; PG8_MMA(1, 0, At, B0); PG8_MMA(1, 1, At, B1); PG8_BAR; PG8_SCHED;
            } else {
            PG8_LDB(B0, 0, 0); PG8_SCHED; PG8_LDA(At, 0, 0); PG8_STAGE(PG8_SA(1, 1), a1 + hstep, voffA);
            PG8_WAIT_L(8); PG8_BAR; PG8_WAIT_L(0); PG8_MMA(0, 0, At, B0); PG8_BAR; PG8_SCHED;
            PG8_LDB(B1, 0, 1); PG8_STAGE(PG8_SB(0, 0), b2, voffB);
            PG8_BAR; PG8_WAIT_L(0); PG8_MMA(0, 1, At, B1); PG8_BAR;
            PG8_LDA(At, 0, 1); PG8_STAGE(PG8_SA(0, 0), a2, voffA);
            PG8_BAR; PG8_WAIT_L(0); PG8_MMA(1, 0, At, B0); PG8_BAR; PG8_SCHED;
            PG8_STAGE(PG8_SB(0, 1), b2 + hstep, voffB);
            PG8_WAIT_V(6); PG8_BAR; PG8_MMA(1, 1, At, B1); PG8_BAR;
            PG8_LDB(B0, 1, 0); PG8_SCHED; PG8_LDA(At, 1, 0); PG8_STAGE(PG8_SA(0, 1), a2 + hstep, voffA);
            PG8_WAIT_L(8); PG8_BAR; PG8_WAIT_L(0); PG8_MMA(0, 0, At, B0); PG8_BAR; PG8_SCHED;
            PG8_LDB(B1, 1, 1); PG8_STAGE(PG8_SB(1, 0), b3, voffB);
            PG8_BAR; PG8_WAIT_L(0); PG8_MMA(0, 1, At, B1); PG8_BAR;
            PG8_LDA(At, 1, 1); PG8_STAGE(PG8_SA(1, 0), a3, voffA);
            PG8_BAR; PG8_WAIT_L(0); PG8_MMA(1, 0, At, B0); PG8_BAR; PG8_SCHED;
            PG8_STAGE(PG8_SB(1, 1), b3 + hstep, voffB);
            PG8_WAIT_V(6); PG8_BAR; PG8_MMA(1, 1, At, B1); PG8_BAR;
            }
        }
        if constexpr (ALIGN_EPI) { if (wr == 0) PG8_BAR; }
        if constexpr (!Epi::AFTER_DRAIN) { E(acc, cur, wr, wc, fr, fq); S.done(cur); }
        if (!has_next) break;
#pragma unroll
        for (int a = 0; a < 2; ++a)
#pragma unroll
            for (int b = 0; b < 2; ++b)
#pragma unroll
                for (int m = 0; m < 4; ++m)
#pragma unroll
                    for (int n = 0; n < 2; ++n) acc[a][b][m][n] = (f32x4){0.f, 0.f, 0.f, 0.f};
        cur = nxt; cA = nA; cB = nB; ++ui;
        if constexpr (ALIGN_EPI) { if (wr == 1) PG8_BAR; }
    }
    PG8_WAIT_V(0);
    if constexpr (!ALIGN_EPI) { if (wr == 0) PG8_BAR; }
    PG8_BAR;
    if constexpr (Epi::AFTER_DRAIN) { E.fused(acc, cur, wr, wc, fr, fq, lds, wid, lane); S.done(cur); }
#undef PG8_SA
#undef PG8_SB
#undef PG8_STAGE
#undef PG8_LDA
#undef PG8_LDB
#undef PG8_MMA
#undef PG8_WAIT_V
#undef PG8_WAIT_L
#undef PG8_BAR
#undef PG8_SCHED
}
}
typedef float f32x2 __attribute__((ext_vector_type(2)));
#define GAS __attribute__((address_space(1)))
#define LAS __attribute__((address_space(3)))
typedef unsigned short bf16;
typedef unsigned v4u __attribute__((ext_vector_type(4)));
typedef float f32x4 __attribute__((ext_vector_type(4)));
typedef short bf16x8 __attribute__((ext_vector_type(8)));
typedef GAS unsigned gu32;
typedef GAS unsigned long long gu64;
#define RLX_AGENT __ATOMIC_RELAXED, __HIP_MEMORY_SCOPE_AGENT
#define LDS_WAIT() asm volatile("s_waitcnt lgkmcnt(0)" ::: "memory")
#define VM_WAIT() asm volatile("s_waitcnt vmcnt(0)" ::: "memory")
__device__ __forceinline__ unsigned long long rt() { return __builtin_amdgcn_s_memrealtime(); }
__device__ __forceinline__ unsigned f2bf(float f) { unsigned u = __builtin_bit_cast(unsigned, f); return (u + 0x7fffu + ((u >> 16) & 1u)) >> 16; }
__device__ __forceinline__ unsigned pk2(float lo, float hi) { return f2bf(lo) | (f2bf(hi) << 16); }
#define XB_TMO      128
#define XB_XCNT(j)  (256  + 64 * (j))
#define XB_XSUB(j)  (1280 + 64 * (j))
#define XB_XGEN(j)  (2304 + 64 * (j))
#define XB_TOP      3328
#define XB_TOPGEN   3392
#define XCD_BAR_WORDS 3456
#define XB_SPIN_CAP (1u << 18)

__device__ __forceinline__ unsigned xb_ld(unsigned* p)              { return __hip_atomic_load(p, __ATOMIC_RELAXED, __HIP_MEMORY_SCOPE_AGENT); }
__device__ __forceinline__ unsigned xb_add(unsigned* p, unsigned v) { return __hip_atomic_fetch_add(p, v, __ATOMIC_RELAXED, __HIP_MEMORY_SCOPE_AGENT); }
__device__ __forceinline__ unsigned xb_xcc_id() { return (unsigned)__builtin_amdgcn_s_getreg((3 << 11) | 20) & 0xFu; }
#define XB_SPIN(cond, bar) do { unsigned _sp = 0; while (cond) { __builtin_amdgcn_s_sleep(1); \
    if ((++_sp & 255u) == 0u) { if (xb_ld(&(bar)[XB_TMO])) break; if (_sp > XB_SPIN_CAP) { atomicAdd(&(bar)[XB_TMO], 1u); break; } } } } while (0)

struct XcdBarrier {
    unsigned* bar; unsigned x;
    volatile LAS unsigned* st;
};

__device__ __forceinline__ XcdBarrier xcd_barrier_post(unsigned* bar, volatile LAS unsigned* st) {
    XcdBarrier b; b.bar = bar; b.x = xb_xcc_id(); b.st = st;
    if (threadIdx.x == 0) (void)xb_add(&bar[XB_XCNT(b.x)], 1u);
    return b;
}
__device__ __forceinline__ void xcd_barrier_complete(unsigned* bar, unsigned x, unsigned& nloc, unsigned& nx) {
    const unsigned G = gridDim.x * gridDim.y * gridDim.z;
    unsigned sum, cnt, mine, sp = 0u;
    for (;;) {
        sum = 0u; cnt = 0u; mine = 0u;
#pragma unroll
        for (unsigned j = 0; j < 16; ++j) { const unsigned c = xb_ld(&bar[XB_XCNT(j)]); sum += c; cnt += (c > 0u) ? 1u : 0u; mine = (j == x) ? c : mine; }
        if (sum == G) break;
        __builtin_amdgcn_s_sleep(1);
        if ((++sp & 255u) == 0u) { if (xb_ld(&bar[XB_TMO])) break; if (sp > XB_SPIN_CAP) { atomicAdd(&bar[XB_TMO], 1u); break; } }
    }
    nloc = mine > 0u ? mine : 1u; nx = cnt > 0u ? cnt : 1u;
}

__device__ __forceinline__ void xcd_barrier(const XcdBarrier& b) {
    asm volatile("s_waitcnt vmcnt(0)" ::: "memory");
    __syncthreads();
    if (threadIdx.x == 0) {
        unsigned* bar = b.bar;
        __builtin_amdgcn_s_waitcnt(0);
        unsigned nloc = b.st[0], nx = b.st[1];
        if (nloc == 0u) { xcd_barrier_complete(bar, b.x, nloc, nx); b.st[0] = nloc; b.st[1] = nx; }
        const unsigned old = xb_add(&bar[XB_XSUB(b.x)], 1u);
        const unsigned gen = old / nloc;
        if (old + 1u == (gen + 1u) * nloc) {
            __builtin_amdgcn_fence(__ATOMIC_RELEASE, "agent");
            asm volatile("s_waitcnt vmcnt(0)" ::: "memory");
            const unsigned og = xb_add(&bar[XB_TOP], 1u);
            const unsigned tg = og / nx;
            if (og + 1u == (tg + 1u) * nx) xb_add(&bar[XB_TOPGEN], 1u);
            else XB_SPIN(xb_ld(&bar[XB_TOPGEN]) == tg, bar);
            __builtin_amdgcn_fence(__ATOMIC_ACQUIRE, "agent");
            xb_add(&bar[XB_XGEN(b.x)], 1u);
            asm volatile("s_waitcnt vmcnt(0)" ::: "memory");
        } else {
            XB_SPIN(xb_ld(&bar[XB_XGEN(b.x)]) == gen, bar);
            __builtin_amdgcn_fence(__ATOMIC_ACQUIRE, "agent");
            asm volatile("s_waitcnt vmcnt(0)" ::: "memory");
        }
    }
    __syncthreads();
}
constexpr int NWAVES = 8, NTHREADS = NWAVES * 64;
constexpr int BATCH = 4, SEQ = 4096, D = 2048, M = BATCH * SEQ;
constexpr int NH = 8, HD = 128, GW = 1024;
constexpr int NPROJ = 8192, NPROJ_SRC = 8208, AB_COL = 4096;
constexpr int FF = 8192;
constexpr float NORM_EPS = 1e-6f, L2_EPS = 1e-6f;
#ifndef MK_N_LAUNCHES
#define MK_N_LAUNCHES 1
#endif
enum { PH_PRO = 0, PH_G1, PH_PREP, PH_LOCAL, PH_SCAN, PH_GNORM, PH_G2, PH_G3, PH_G4, PH_FIN, N_PHASES };
constexpr int N_LAUNCHES = MK_N_LAUNCHES;

constexpr size_t MiB = 1u << 20;
constexpr size_t WS_CTL = 0, CTL_ZERO_BYTES = 1 * MiB;
constexpr size_t WS_AB = 1 * MiB;
constexpr size_t WS_WIN = 2 * MiB, WS_WOUT = 34 * MiB, WS_W1 = 42 * MiB, WS_W2 = 74 * MiB;
constexpr size_t WS_SS1 = 106 * MiB, WS_SS2 = 108 * MiB;
constexpr size_t WS_DEC = 110 * MiB, WS_BETA = WS_DEC + 512 * 1024;
constexpr size_t WS_XN = 112 * MiB;
constexpr size_t WS_Y = 176 * MiB;
constexpr size_t WS_PROJ = 240 * MiB, PROJ_SLOT = 32 * MiB;
constexpr size_t WS_DTAB = 111 * MiB;
constexpr size_t WS_HVT = WS_Y, WS_TM = WS_Y + 32 * MiB, WS_ATT = WS_Y + 48 * MiB;
constexpr size_t WS_HA = 496 * MiB;
constexpr size_t WS_END = 512 * MiB;
constexpr int CW_BAR = 4096;

constexpr int RING_BYTES = 131072, TAB_OFF = 143360  , LDSCTL_OFF = TAB_OFF + 4096, MISC_OFF = LDSCTL_OFF + 320, OST_OFF = LDSCTL_OFF + 1024  , LDS_BYTES = 163840;

typedef float f32x16 __attribute__((ext_vector_type(16)));
typedef __bf16 bf16x2_t __attribute__((ext_vector_type(2)));
#define MFMA32(a, b, c) __builtin_amdgcn_mfma_f32_32x32x16_bf16((a), (b), (c), 0, 0, 0)
__device__ __forceinline__ unsigned cvt2(float lo, float hi) { const f32x2 v = {lo, hi}; return __builtin_bit_cast(unsigned, __builtin_convertvector(v, bf16x2_t)); }
__device__ __forceinline__ int perm16(int o) { return (o & 3) | ((o & 4) << 1) | ((o & 8) >> 1); }
__device__ __forceinline__ float wave_sum(float v) {
    v += __builtin_bit_cast(float, __builtin_amdgcn_update_dpp(0, __builtin_bit_cast(int, v), 0xB1, 0xf, 0xf, true));
    v += __builtin_bit_cast(float, __builtin_amdgcn_update_dpp(0, __builtin_bit_cast(int, v), 0x4E, 0xf, 0xf, true));
    v += __builtin_bit_cast(float, __builtin_amdgcn_update_dpp(0, __builtin_bit_cast(int, v), 0x141, 0xf, 0xf, true));
    v += __builtin_bit_cast(float, __builtin_amdgcn_update_dpp(0, __builtin_bit_cast(int, v), 0x140, 0xf, 0xf, true));
    v += __builtin_bit_cast(float, __builtin_amdgcn_update_dpp(0, __builtin_bit_cast(int, v), 0x142, 0xa, 0xf, false));
    v += __builtin_bit_cast(float, __builtin_amdgcn_update_dpp(0, __builtin_bit_cast(int, v), 0x143, 0xc, 0xf, false));
    return __builtin_bit_cast(float, __builtin_amdgcn_readlane(__builtin_bit_cast(int, v), 63));
}
__device__ __forceinline__ float bf_lo(unsigned u) { return __builtin_bit_cast(float, u << 16); }
__device__ __forceinline__ float bf_hi(unsigned u) { return __builtin_bit_cast(float, u & 0xffff0000u); }
__device__ __forceinline__ float sigmoidf_(float x) { return __builtin_amdgcn_rcpf(1.0f + __expf(-x)); }
__device__ __forceinline__ float siluf_(float x) { return x * __builtin_amdgcn_rcpf(1.0f + __expf(-x)); }
template <int CTRL> __device__ __forceinline__ float dpp_add(float v) {
    const int r = __builtin_amdgcn_update_dpp(0, __builtin_bit_cast(int, v), CTRL, 0xf, 0xf, true);
    return v + __builtin_bit_cast(float, r);
}
__device__ __forceinline__ float red16(float v) {
    v = dpp_add<0xB1>(v); v = dpp_add<0x4E>(v); v = dpp_add<0x141>(v); v = dpp_add<0x140>(v); return v;
}

__device__ __forceinline__ void transpose_item(const float* W, int ldw, int srccol0, int k0, bf16* WT, int ldt, int dstrow0, const float* kscale, LAS float* scr, int lane) {
    float tv[32];
#pragma unroll
    for (int i = 0; i < 32; ++i) tv[i] = W[(size_t)(k0 + 2 * i + (lane >> 5)) * ldw + srccol0 + (lane & 31)];
    if (kscale) {
#pragma unroll
        for (int i = 0; i < 32; ++i) tv[i] *= kscale[k0 + 2 * i + (lane >> 5)];
    }
#pragma unroll
    for (int i = 0; i < 32; ++i) scr[(2 * i + (lane >> 5)) * 33 + (lane & 31)] = tv[i];
    LDS_WAIT(); asm volatile("" ::: "memory");
    const int c = lane & 7;
#pragma unroll
    for (int j = 0; j < 4; ++j) { const int n = (lane >> 3) + 8 * j; const LAS float* s = scr + (8 * c) * 33 + n;
        v4u o; o.x = pk2(s[0 * 33], s[1 * 33]); o.y = pk2(s[2 * 33], s[3 * 33]); o.z = pk2(s[4 * 33], s[5 * 33]); o.w = pk2(s[6 * 33], s[7 * 33]);
        *(GAS v4u*)(WT + (size_t)(dstrow0 + n) * ldt + k0 + 8 * c) = o; }
    LDS_WAIT(); asm volatile("" ::: "memory");
}

struct Args { const float* in[14]; float* out; unsigned char* ws; int ph_lo, ph_hi, li, pad; };

__global__ void __launch_bounds__(NTHREADS, 2) hyb_fwd(Args args) {
    extern __shared__ __attribute__((aligned(16))) unsigned char lds_raw[];
    LAS unsigned char* lds = (LAS unsigned char*)lds_raw;
    volatile LAS unsigned* MISC = (volatile LAS unsigned*)(lds + MISC_OFF);
    const int tid = threadIdx.x, lane = tid & 63, wave = __builtin_amdgcn_readfirstlane(tid >> 6);
    const int G = gridDim.x; const int bx = blockIdx.x; const int vcu = (G % 8 == 0) ? (bx % 8) * (G / 8) + bx / 8 : bx;
    const int gw = vcu * NWAVES + wave, NGW = G * NWAVES;
    unsigned char* ws = args.ws;
    gu32* ctl = (gu32*)(ws + WS_CTL);
    const float* x = args.in[0]; const float* w_in = args.in[1]; const float* conv_w = args.in[2]; const float* a_log = args.in[3]; const float* dt_bias = args.in[4];
    const float* gdn_nw = args.in[5]; const float* lb_logits = args.in[6]; const float* hgrn_nw = args.in[7]; const float* w_out = args.in[8];
    const float* w_mix = args.in[9]; const float* w_ffn = args.in[10]; const float* w1 = args.in[11]; const float* w2 = args.in[12]; const float* w_fin = args.in[13];
    float* out = args.out;
    bf16* WIN_T = (bf16*)(ws + WS_WIN); bf16* WOUT_T = (bf16*)(ws + WS_WOUT); bf16* W1_T = (bf16*)(ws + WS_W1); bf16* W2_T = (bf16*)(ws + WS_W2);
    float* AB = (float*)(ws + WS_AB); float* SS1 = (float*)(ws + WS_SS1); float* SS2 = (float*)(ws + WS_SS2);
    float* DEC = (float*)(ws + WS_DEC); float* BETA = (float*)(ws + WS_BETA);
    bf16* XN = (bf16*)(ws + WS_XN); float* VF = out; bf16* HB = (bf16*)(ws + WS_XN);
    bf16* Y = (bf16*)(ws + WS_Y);
    bf16* PROJ = (bf16*)(ws + WS_PROJ); float* OB = (float*)(ws + WS_PROJ); bf16* ACT = (bf16*)(ws + WS_PROJ);
    bf16* OA = PROJ + (size_t)2 * ((size_t)M * GW); bf16* OBH = PROJ;
    float* DTAB = (float*)(ws + WS_DTAB); bf16* HVT = (bf16*)(ws + WS_HVT); bf16* TM = (bf16*)(ws + WS_TM); bf16* ATT = (bf16*)(ws + WS_ATT); bf16* HA = (bf16*)(ws + WS_HA);
    bf16* QR = (bf16*)(ws + WS_XN); bf16* KR = QR + (size_t)M * GW; bf16* KT = (bf16*)(out + (size_t)M * GW); bf16* HKT = KT + (size_t)M * GW; float* GG = DEC;
#define PSLOT(i) (PROJ + (size_t)(i) * ((size_t)M * GW))

    for (int u = tid; u < (LDS_BYTES - LDSCTL_OFF) / 4; u += NTHREADS) ((LAS unsigned*)(lds + LDSCTL_OFF))[u] = 0u;
    __syncthreads();
    XcdBarrier bar; bar.bar = (unsigned*)(ctl + CW_BAR); bar.x = 0; bar.st = nullptr;
    if (N_LAUNCHES == 1) bar = xcd_barrier_post((unsigned*)(ctl + CW_BAR), MISC + 8);
    const int lo = args.ph_lo, hi = args.ph_hi;
#define IN(k) (lo <= (k) && (k) < hi)
#define SEAM(k) do { if (IN(k) && IN((k) + 1)) xcd_barrier(bar); } while (0)

    if (IN(PH_PRO)) {
        {
            LAS float* scr = (LAS float*)(lds + wave * 16384);
            constexpr int I_IN = (D / 64) * (NPROJ / 32);
            for (int it = gw; it < I_IN; it += NGW) { const int kb = it / (NPROJ / 32), nb = it % (NPROJ / 32), n0 = 32 * nb; transpose_item(w_in, NPROJ_SRC, n0 + (n0 >= AB_COL ? 16 : 0), 64 * kb, WIN_T, D, n0, nullptr, scr, lane); }
        }
        __syncthreads();
        {
            LAS float* wab = (LAS float*)lds;
#pragma unroll
            for (int i = 0; i < 4; ++i) { const int k = tid + NTHREADS * i; const f32x4* src = (const f32x4*)(w_in + (size_t)k * NPROJ_SRC + AB_COL);
#pragma unroll
                for (int q = 0; q < 4; ++q) { const f32x4 v = src[q]; wab[(4 * q + 0) * D + k] = v[0]; wab[(4 * q + 1) * D + k] = v[1]; wab[(4 * q + 2) * D + k] = v[2]; wab[(4 * q + 3) * D + k] = v[3]; } }
            __syncthreads();
            f32x4 wm[8];
#pragma unroll
            for (int j = 0; j < 8; ++j) wm[j] = *(const f32x4*)(w_mix + 256 * j + 4 * lane);
            for (int rp = 0; rp < 4; ++rp) {
                const int m0 = gw * 8 + rp * 2;
                if (m0 >= M) break;
                f32x4 n0[8], n1[8]; float s0 = 0.f, s1 = 0.f;
#pragma unroll
                for (int j = 0; j < 8; ++j) { n0[j] = *(const f32x4*)(x + (size_t)m0 * D + 256 * j + 4 * lane); n1[j] = *(const f32x4*)(x + (size_t)(m0 + 1) * D + 256 * j + 4 * lane); }
#pragma unroll
                for (int j = 0; j < 8; ++j) { s0 += (n0[j][0] * n0[j][0] + n0[j][1] * n0[j][1]) + (n0[j][2] * n0[j][2] + n0[j][3] * n0[j][3]); s1 += (n1[j][0] * n1[j][0] + n1[j][1] * n1[j][1]) + (n1[j][2] * n1[j][2] + n1[j][3] * n1[j][3]); }
                const float r0 = 1.0f / sqrtf(wave_sum(s0) * (1.0f / D) + NORM_EPS), r1 = 1.0f / sqrtf(wave_sum(s1) * (1.0f / D) + NORM_EPS);
#pragma unroll
                for (int j = 0; j < 8; ++j) { n0[j] = n0[j] * r0 * wm[j]; n1[j] = n1[j] * r1 * wm[j];
                    *(GAS unsigned long long*)(XN + (size_t)m0 * D + 256 * j + 4 * lane) = (unsigned long long)pk2(n0[j][0], n0[j][1]) | ((unsigned long long)pk2(n0[j][2], n0[j][3]) << 32);
                    *(GAS unsigned long long*)(XN + (size_t)(m0 + 1) * D + 256 * j + 4 * lane) = (unsigned long long)pk2(n1[j][0], n1[j][1]) | ((unsigned long long)pk2(n1[j][2], n1[j][3]) << 32); }
                float acc[32];
#pragma unroll
                for (int c = 0; c < 16; ++c) { float a0 = 0.f, a1 = 0.f;
#pragma unroll
                    for (int j = 0; j < 8; ++j) { const f32x4 w4 = *(const LAS f32x4*)(wab + c * D + 256 * j + 4 * lane);
                        a0 += (n0[j][0] * w4[0] + n0[j][1] * w4[1]) + (n0[j][2] * w4[2] + n0[j][3] * w4[3]); a1 += (n1[j][0] * w4[0] + n1[j][1] * w4[1]) + (n1[j][2] * w4[2] + n1[j][3] * w4[3]); }
                    acc[c] = a0; acc[16 + c] = a1; }
#pragma unroll
                for (int i = 0; i < 16; ++i) { const bool up = (lane & 32) != 0; const float keep = up ? acc[16 + i] : acc[i], send = up ? acc[i] : acc[16 + i]; acc[i] = keep + __shfl_xor(send, 32); }
#pragma unroll
                for (int i = 0; i < 8; ++i) { const bool up = (lane & 16) != 0; const float keep = up ? acc[8 + i] : acc[i], send = up ? acc[i] : acc[8 + i]; acc[i] = keep + __shfl_xor(send, 16); }
#pragma unroll
                for (int i = 0; i < 4; ++i) { const bool up = (lane & 8) != 0; const float keep = up ? acc[4 + i] : acc[i], send = up ? acc[i] : acc[4 + i]; acc[i] = keep + __shfl_xor(send, 8); }
#pragma unroll
                for (int i = 0; i < 2; ++i) { const bool up = (lane & 4) != 0; const float keep = up ? acc[2 + i] : acc[i], send = up ? acc[i] : acc[2 + i]; acc[i] = keep + __shfl_xor(send, 4); }
                { const bool up = (lane & 2) != 0; const float keep = up ? acc[1] : acc[0], send = up ? acc[0] : acc[1]; acc[0] = keep + __shfl_xor(send, 2); }
                acc[0] += __shfl_xor(acc[0], 1);
                if ((lane & 1) == 0) { const int i = lane >> 1; AB[(size_t)(m0 + (i >> 4)) * 16 + (i & 15)] = acc[0]; }
            }
        }
        __syncthreads();
    }
    SEAM(PH_PRO);

    if (IN(PH_G1)) {
        pg8::Gemm g{XN, WIN_T, M, NPROJ, D}; pg8::StaticOrder S; S.init(M, NPROJ, G, bx);
        pg8::EpiBf16Split E{PROJ, GW, GW, (size_t)M * GW};
        pg8::gemm_phase<pg8::EpiBf16Split, pg8::StaticOrder, true, true>(lds, g, S, E);
    }
    SEAM(PH_G1);

    if (IN(PH_PREP)) {
        for (int task = gw; task < 8 * (M / 64); task += NGW) {
            const int cidx = task >> 3, h = task & 7, bh = (cidx >> 6) * 8 + h, cs = cidx & 63, m0 = cidx * 64;
            {
                const float ar = AB[(size_t)(m0 + lane) * 16 + h], br = AB[(size_t)(m0 + lane) * 16 + 8 + h];
                const float z = ar + dt_bias[h]; const float sp = fmaxf(z, 0.f) + log1pf(__expf(-fabsf(z)));
                float gsum = -__expf(a_log[h]) * sp;
#pragma unroll
                for (int o = 1; o < 64; o <<= 1) { const float t = __shfl_up(gsum, o); if (lane >= o) gsum += t; }
                GG[(size_t)(m0 + lane) * 8 + h] = gsum; BETA[(size_t)(m0 + lane) * 8 + h] = sigmoidf_(br);
            }
            const int c0 = h * HD + 2 * lane, pc = h * HD + ((2 * lane) & ~15) + perm16((2 * lane) & 15);
            float cw[3][4][2];
#pragma unroll
            for (int X = 0; X < 3; ++X)
#pragma unroll
                for (int j = 0; j < 4; ++j) { const float* p = conv_w + (size_t)j * (3 * GW) + X * GW + c0; cw[X][j][0] = p[0]; cw[X][j][1] = p[1]; }
            float r[3][4][2];
#pragma unroll
            for (int X = 0; X < 3; ++X)
#pragma unroll
                for (int j = 0; j < 3; ++j) { unsigned u = 0u; if (cs * 64 - 3 + j >= 0) u = *(const unsigned*)(PSLOT(X) + (size_t)(m0 - 3 + j) * GW + c0); r[X][j][0] = bf_lo(u); r[X][j][1] = bf_hi(u); }
            bf16* kt = KT + (size_t)(bh * HD + 2 * lane) * SEQ + cs * 64;
            unsigned kp0[32], kp1[32];
#pragma unroll
            for (int g4 = 0; g4 < 4; ++g4) {
                float kl0 = 0.f, kl1 = 0.f;
                unsigned uc[3][16];
#pragma unroll
                for (int ii = 0; ii < 16; ++ii)
#pragma unroll
                    for (int X = 0; X < 3; ++X) uc[X][ii] = *(const unsigned*)(PSLOT(X) + (size_t)(m0 + g4 * 16 + ii) * GW + c0);
#pragma unroll
                for (int ii = 0; ii < 16; ++ii) {
                    const size_t rowo = (size_t)(m0 + g4 * 16 + ii) * GW; float o[3][2];
#pragma unroll
                    for (int X = 0; X < 3; ++X) { const unsigned u = uc[X][ii]; r[X][3][0] = bf_lo(u); r[X][3][1] = bf_hi(u);
#pragma unroll
                        for (int e = 0; e < 2; ++e) { const float c = (cw[X][0][e] * r[X][0][e] + cw[X][1][e] * r[X][1][e]) + (cw[X][2][e] * r[X][2][e] + cw[X][3][e] * r[X][3][e]); o[X][e] = siluf_(c); }
#pragma unroll
                        for (int j = 0; j < 3; ++j) { r[X][j][0] = r[X][j + 1][0]; r[X][j][1] = r[X][j + 1][1]; } }
                    const float sq = wave_sum(o[0][0] * o[0][0] + o[0][1] * o[0][1]), sk = wave_sum(o[1][0] * o[1][0] + o[1][1] * o[1][1]);
                    const float rq = __builtin_amdgcn_rsqf(sq + L2_EPS) * 0.08838834764831845f, rk = __builtin_amdgcn_rsqf(sk + L2_EPS);
                    const float k0 = o[1][0] * rk, k1 = o[1][1] * rk;
                    *(unsigned*)(QR + rowo + pc) = cvt2(o[0][0] * rq, o[0][1] * rq); *(unsigned*)(KR + rowo + pc) = cvt2(k0, k1);
                    *(f32x2*)(VF + rowo + c0) = (f32x2){o[2][0], o[2][1]};
                    if ((ii & 1) == 0) { kl0 = k0; kl1 = k1; } else { kp0[8 * g4 + (ii >> 1)] = cvt2(kl0, k0); kp1[8 * g4 + (ii >> 1)] = cvt2(kl1, k1); }
                }
            }
#pragma unroll
            for (int g4 = 0; g4 < 4; ++g4) { *(v4u*)(kt + g4 * 16) = (v4u){kp0[8 * g4 + 0], kp0[8 * g4 + 1], kp0[8 * g4 + 4], kp0[8 * g4 + 5]}; *(v4u*)(kt + g4 * 16 + 8) = (v4u){kp0[8 * g4 + 2], kp0[8 * g4 + 3], kp0[8 * g4 + 6], kp0[8 * g4 + 7]}; }
#pragma unroll
            for (int g4 = 0; g4 < 4; ++g4) { *(v4u*)(kt + SEQ + g4 * 16) = (v4u){kp1[8 * g4 + 0], kp1[8 * g4 + 1], kp1[8 * g4 + 4], kp1[8 * g4 + 5]}; *(v4u*)(kt + SEQ + g4 * 16 + 8) = (v4u){kp1[8 * g4 + 2], kp1[8 * g4 + 3], kp1[8 * g4 + 6], kp1[8 * g4 + 7]}; }
        }
        for (int task = gw; task < 8 * (M / 64); task += NGW) {
            const int cidx = task >> 3, h = task & 7, bh = (cidx >> 6) * 8 + h, cs = cidx & 63;
            const int c0 = h * HD + 2 * lane, pc = h * HD + ((2 * lane) & ~15) + perm16((2 * lane) & 15);
            const float lb0 = 1.0f / (1.0f + __expf(lb_logits[GW + c0] - lb_logits[c0])), lb1 = 1.0f / (1.0f + __expf(lb_logits[GW + c0 + 1] - lb_logits[c0 + 1]));
            float bs0 = 1.0f, bs1 = 1.0f;
            bf16* hkt = HKT + (size_t)(bh * HD + 2 * lane) * SEQ + cs * 64; bf16* hvt = HVT + (size_t)(bh * HD + 2 * lane) * SEQ + cs * 64;
            unsigned kp0[32], kp1[32], vp0[32], vp1[32];
#pragma unroll
            for (int g4 = 0; g4 < 4; ++g4) {
                float kl0 = 0.f, kl1 = 0.f; unsigned vl = 0u;
                unsigned uc[3][16];
#pragma unroll
                for (int ii = 0; ii < 16; ++ii)
#pragma unroll
                    for (int X = 0; X < 3; ++X) uc[X][ii] = *(const unsigned*)(PSLOT(4 + X) + (size_t)(cidx * 64 + g4 * 16 + ii) * GW + c0);
#pragma unroll
                for (int ii = 0; ii < 16; ++ii) {
                    const size_t rowo = (size_t)(cidx * 64 + g4 * 16 + ii) * GW;
                    const unsigned qu = uc[0][ii], fu = uc[1][ii], vu = uc[2][ii];
                    const float fg0 = lb0 + (1.0f - lb0) * sigmoidf_(bf_lo(fu)), fg1 = lb1 + (1.0f - lb1) * sigmoidf_(bf_hi(fu));
                    bs0 *= fg0; bs1 *= fg1;
                    const float qt0 = siluf_(bf_lo(qu)) * bs0, qt1 = siluf_(bf_hi(qu)) * bs1;
                    const float kt0 = (1.0f - fg0) * __builtin_amdgcn_rcpf(bs0), kt1 = (1.0f - fg1) * __builtin_amdgcn_rcpf(bs1);
                    *(unsigned*)(PSLOT(4) + rowo + pc) = cvt2(qt0, qt1); *(unsigned*)(PSLOT(5) + rowo + pc) = cvt2(kt0, kt1);
                    if ((ii & 1) == 0) { kl0 = kt0; kl1 = kt1; vl = vu; }
                    else { kp0[8 * g4 + (ii >> 1)] = cvt2(kl0, kt0); kp1[8 * g4 + (ii >> 1)] = cvt2(kl1, kt1); vp0[8 * g4 + (ii >> 1)] = (vl & 0xffffu) | (vu << 16); vp1[8 * g4 + (ii >> 1)] = (vl >> 16) | (vu & 0xffff0000u); }
                }
            }
#pragma unroll
            for (int q8 = 0; q8 < 8; ++q8) *(v4u*)(hkt + 8 * q8) = (v4u){kp0[4 * q8], kp0[4 * q8 + 1], kp0[4 * q8 + 2], kp0[4 * q8 + 3]};
#pragma unroll
            for (int q8 = 0; q8 < 8; ++q8) *(v4u*)(hkt + SEQ + 8 * q8) = (v4u){kp1[4 * q8], kp1[4 * q8 + 1], kp1[4 * q8 + 2], kp1[4 * q8 + 3]};
#pragma unroll
            for (int q8 = 0; q8 < 8; ++q8) *(v4u*)(hvt + 8 * q8) = (v4u){vp0[4 * q8], vp0[4 * q8 + 1], vp0[4 * q8 + 2], vp0[4 * q8 + 3]};
#pragma unroll
            for (int q8 = 0; q8 < 8; ++q8) *(v4u*)(hvt + SEQ + 8 * q8) = (v4u){vp1[4 * q8], vp1[4 * q8 + 1], vp1[4 * q8 + 2], vp1[4 * q8 + 3]};
            *(f32x2*)(DTAB + (size_t)task * HD + 2 * lane) = (f32x2){bs0, bs1};
        }
    }
    if (IN(PH_PREP) && IN(PH_LOCAL)) { asm volatile("s_waitcnt vmcnt(0)" ::: "memory"); __builtin_amdgcn_fence(__ATOMIC_ACQUIRE, "agent"); asm volatile("s_waitcnt vmcnt(0)" ::: "memory"); }
    else SEAM(PH_PREP);

    if (IN(PH_LOCAL)) {
        const int r = lane & 31, hl = lane >> 5;
        for (int task = gw; task < 8 * (M / 64); task += NGW) {
            const int cidx = task >> 3, h = task & 7; const size_t row0 = (size_t)cidx * 64;
            LAS float* LT = (LAS float*)(lds + wave * 16384);
            LAS float* tb = (LAS float*)(lds + TAB_OFF + wave * 512);
            tb[lane] = GG[(row0 + lane) * 8 + h]; tb[64 + lane] = BETA[(row0 + lane) * 8 + h];
            f32x16 kk00, kk01, kk11, qk00, qk01, qk11;
            {
                bf16x8 kf[2][8];
                const bf16* kbase = KR + (row0 + r) * GW + h * HD + 8 * hl; const bf16* qbase = QR + (row0 + r) * GW + h * HD + 8 * hl;
#pragma unroll
                for (int it = 0; it < 2; ++it)
#pragma unroll
                    for (int s = 0; s < 8; ++s) kf[it][s] = *(const bf16x8*)(kbase + (size_t)(32 * it) * GW + 16 * s);
#pragma unroll
                for (int e = 0; e < 16; ++e) { kk00[e] = 0.f; kk01[e] = 0.f; kk11[e] = 0.f; qk00[e] = 0.f; qk01[e] = 0.f; qk11[e] = 0.f; }
#pragma unroll
                for (int s = 0; s < 8; ++s) { kk00 = MFMA32(kf[0][s], kf[0][s], kk00); kk01 = MFMA32(kf[0][s], kf[1][s], kk01); kk11 = MFMA32(kf[1][s], kf[1][s], kk11); }
#pragma unroll
                for (int s = 0; s < 8; ++s) { const bf16x8 q0 = *(const bf16x8*)(qbase + 16 * s), q1 = *(const bf16x8*)(qbase + (size_t)32 * GW + 16 * s);
                    qk00 = MFMA32(kf[0][s], q0, qk00); qk01 = MFMA32(kf[0][s], q1, qk01); qk11 = MFMA32(kf[1][s], q1, qk11); }
            }
            LDS_WAIT(); asm volatile("" ::: "memory");
            const float gi0 = tb[r], gi1 = tb[32 + r], bi0 = tb[64 + r], bi1 = tb[96 + r];
            bf16* att = ATT + (size_t)task * 4096;
#pragma unroll
            for (int a = 0; a < 4; ++a) {
                const int j0 = 8 * a + 4 * hl; const f32x4 gj0 = *(const LAS f32x4*)(tb + j0), gj1 = *(const LAS f32x4*)(tb + 32 + j0);
                const int pj0 = (j0 & ~15) + perm16(j0 & 15);
                float l00[4], l01[4], l11[4], a00[4], a01[4], a11[4];
#pragma unroll
                for (int e = 0; e < 4; ++e) { const int j = j0 + e;
                    const float d00 = __expf(fminf(gi0 - gj0[e], 0.f)), d01 = __expf(fminf(gi1 - gj0[e], 0.f)), d11 = __expf(fminf(gi1 - gj1[e], 0.f));
                    l00[e] = (j < r) ? bi0 * kk00[4 * a + e] * d00 : 0.f; l01[e] = bi1 * kk01[4 * a + e] * d01; l11[e] = (j < r) ? bi1 * kk11[4 * a + e] * d11 : 0.f;
                    a00[e] = (j <= r) ? qk00[4 * a + e] * d00 : 0.f; a01[e] = qk01[4 * a + e] * d01; a11[e] = (j <= r) ? qk11[4 * a + e] * d11 : 0.f;
                    LT[(j) * 64 + r] = l00[e]; LT[(j) * 64 + 32 + r] = l01[e]; LT[(32 + j) * 64 + 32 + r] = l11[e]; LT[(32 + j) * 64 + r] = 0.f; }
                *(uint2*)(att + (size_t)r * 64 + pj0) = make_uint2(cvt2(a00[0], a00[1]), cvt2(a00[2], a00[3]));
                *(uint2*)(att + (size_t)r * 64 + 32 + pj0) = make_uint2(0u, 0u);
                *(uint2*)(att + (size_t)(32 + r) * 64 + pj0) = make_uint2(cvt2(a01[0], a01[1]), cvt2(a01[2], a01[3]));
                *(uint2*)(att + (size_t)(32 + r) * 64 + 32 + pj0) = make_uint2(cvt2(a11[0], a11[1]), cvt2(a11[2], a11[3]));
            }
            LDS_WAIT(); asm volatile("" ::: "memory");
            for (int j = 63; j >= 0; --j) {
                float acc = (lane == j) ? 1.0f : 0.f;
                for (int q = (j + 1) >> 2; q < 16; ++q) { const f32x4 lv = *(const LAS f32x4*)(LT + j * 64 + 4 * q);
                    const float t0 = LT[(4 * q + 0) * 64 + lane], t1 = LT[(4 * q + 1) * 64 + lane], t2 = LT[(4 * q + 2) * 64 + lane], t3 = LT[(4 * q + 3) * 64 + lane];
                    acc -= t0 * lv[0]; acc -= t1 * lv[1]; acc -= t2 * lv[2]; acc -= t3 * lv[3]; }
                LDS_WAIT(); asm volatile("" ::: "memory");
                LT[j * 64 + lane] = acc;
                LDS_WAIT(); asm volatile("" ::: "memory");
            }
            bf16* tm = TM + (size_t)task * 4096 + (size_t)lane * 64;
#pragma unroll
            for (int g = 0; g < 4; ++g) {
                float tr[16];
#pragma unroll
                for (int e = 0; e < 16; ++e) tr[e] = LT[(16 * g + e) * 64 + lane];
                *(v4u*)(tm + 16 * g) = (v4u){cvt2(tr[0], tr[1]), cvt2(tr[2], tr[3]), cvt2(tr[8], tr[9]), cvt2(tr[10], tr[11])};
                *(v4u*)(tm + 16 * g + 8) = (v4u){cvt2(tr[4], tr[5]), cvt2(tr[6], tr[7]), cvt2(tr[12], tr[13]), cvt2(tr[14], tr[15])}; }
            {
                tb[lane] = -tb[64 + lane] * __expf(tb[lane]);
                LDS_WAIT(); asm volatile("" ::: "memory");
                bf16x8 bfr[2][4];
#pragma unroll
                for (int it = 0; it < 2; ++it)
#pragma unroll
                    for (int s = 0; s < 4; ++s) { float v[8];
#pragma unroll
                        for (int jj = 0; jj < 8; ++jj) { const int tkn = 16 * s + perm16(8 * hl + jj); v[jj] = LT[tkn * 64 + 32 * it + r] * tb[tkn]; }
                        bfr[it][s] = __builtin_bit_cast(bf16x8, (v4u){cvt2(v[0], v[1]), cvt2(v[2], v[3]), cvt2(v[4], v[5]), cvt2(v[6], v[7])}); }
                const int bh = (cidx >> 6) * 8 + h, cs = cidx & 63;
#pragma unroll
                for (int dt = 0; dt < 4; ++dt) {
                    bf16x8 af[4];
#pragma unroll
                    for (int s = 0; s < 4; ++s) af[s] = *(const bf16x8*)(KT + (size_t)(bh * HD + 32 * dt + r) * SEQ + cs * 64 + 16 * s + 8 * hl);
                    f32x16 w0, w1;
#pragma unroll
                    for (int e = 0; e < 16; ++e) { w0[e] = 0.f; w1[e] = 0.f; }
#pragma unroll
                    for (int s = 0; s < 4; ++s) { w0 = MFMA32(af[s], bfr[0][s], w0); w1 = MFMA32(af[s], bfr[1][s], w1); }
#pragma unroll
                    for (int a = 0; a < 4; ++a) { const int d0 = 8 * a + 4 * hl; const int pd = 32 * dt + (d0 & ~15) + perm16(d0 & 15);
                        *(uint2*)(KR + (row0 + r) * GW + h * HD + pd) = make_uint2(cvt2(w0[4 * a], w0[4 * a + 1]), cvt2(w0[4 * a + 2], w0[4 * a + 3]));
                        *(uint2*)(KR + (row0 + 32 + r) * GW + h * HD + pd) = make_uint2(cvt2(w1[4 * a], w1[4 * a + 1]), cvt2(w1[4 * a + 2], w1[4 * a + 3])); }
                }
            }
            LDS_WAIT(); asm volatile("" ::: "memory");
        }
        for (int task = gw; task < 8 * (M / 64); task += NGW) {
            const int cidx = task >> 3, h = task & 7; const size_t row0 = (size_t)cidx * 64;
            bf16x8 kf[2][8];
            const bf16* kbase = PSLOT(5) + (row0 + r) * GW + h * HD + 8 * hl; const bf16* qbase = PSLOT(4) + (row0 + r) * GW + h * HD + 8 * hl;
#pragma unroll
            for (int it = 0; it < 2; ++it)
#pragma unroll
                for (int s = 0; s < 8; ++s) kf[it][s] = *(const bf16x8*)(kbase + (size_t)(32 * it) * GW + 16 * s);
            f32x16 t00, t01, t11;
#pragma unroll
            for (int e = 0; e < 16; ++e) { t00[e] = 0.f; t01[e] = 0.f; t11[e] = 0.f; }
#pragma unroll
            for (int s = 0; s < 8; ++s) { const bf16x8 q0 = *(const bf16x8*)(qbase + 16 * s), q1 = *(const bf16x8*)(qbase + (size_t)32 * GW + 16 * s);
                t00 = MFMA32(kf[0][s], q0, t00); t01 = MFMA32(kf[0][s], q1, t01); t11 = MFMA32(kf[1][s], q1, t11); }
            bf16* ha = HA + (size_t)task * 4096;
#pragma unroll
            for (int a = 0; a < 4; ++a) { const int j0 = 8 * a + 4 * hl; float v[4];
#pragma unroll
                for (int e = 0; e < 4; ++e) v[e] = (j0 + e <= r) ? t00[4 * a + e] : 0.f;
                *(uint2*)(ha + (size_t)r * 64 + j0) = make_uint2(cvt2(v[0], v[1]), cvt2(v[2], v[3]));
                *(uint2*)(ha + (size_t)r * 64 + 32 + j0) = make_uint2(0u, 0u);
                *(uint2*)(ha + (size_t)(32 + r) * 64 + j0) = make_uint2(cvt2(t01[4 * a], t01[4 * a + 1]), cvt2(t01[4 * a + 2], t01[4 * a + 3]));
#pragma unroll
                for (int e = 0; e < 4; ++e) v[e] = (j0 + e <= r) ? t11[4 * a + e] : 0.f;
                *(uint2*)(ha + (size_t)(32 + r) * 64 + 32 + j0) = make_uint2(cvt2(v[0], v[1]), cvt2(v[2], v[3])); }
        }
    }
    SEAM(PH_LOCAL);

    if (IN(PH_SCAN)) {
        if (bx >= 64) {
            LAS float* scr = (LAS float*)(lds + wave * 16384);
            constexpr int I_OUT = (D / 64) * (D / 32), I_1 = (D / 64) * (FF / 32), I_2 = (FF / 64) * (D / 32);
            for (int it = (bx - 64) * NWAVES + wave; it < I_OUT + I_1 + I_2; it += (G - 64) * NWAVES) {
                int q = it;
                if (q < I_OUT) { const int kb = q / (D / 32), nb = q % (D / 32); transpose_item(w_out, D, 32 * nb, 64 * kb, WOUT_T, D, 32 * nb, nullptr, scr, lane); continue; } q -= I_OUT;
                if (q < I_1) { const int kb = q / (FF / 32), nb = q % (FF / 32); transpose_item(w1, FF, 32 * nb, 64 * kb, W1_T, D, 32 * nb, w_ffn, scr, lane); continue; } q -= I_1;
                { const int kb = q / (D / 32), nb = q % (D / 32); transpose_item(w2, D, 32 * nb, 64 * kb, W2_T, FF, 32 * nb, nullptr, scr, lane); }
            }
        }
        constexpr int RS = 272, RH = 144, SBUF = 71680;
        const f32x16 Z16 = {0.f, 0.f, 0.f, 0.f, 0.f, 0.f, 0.f, 0.f, 0.f, 0.f, 0.f, 0.f, 0.f, 0.f, 0.f, 0.f};
#define SFRAG(dst, s_) do { const int bse_ = 8 * ((s_) & 1); v4u w_; w_.x = cvt2(S[(s_) >> 1][bse_ + 0], S[(s_) >> 1][bse_ + 1]); w_.y = cvt2(S[(s_) >> 1][bse_ + 2], S[(s_) >> 1][bse_ + 3]); \
        w_.z = cvt2(S[(s_) >> 1][bse_ + 4], S[(s_) >> 1][bse_ + 5]); w_.w = cvt2(S[(s_) >> 1][bse_ + 6], S[(s_) >> 1][bse_ + 7]); dst = __builtin_bit_cast(bf16x8, w_); } while (0)
#define TFRAG(dst, t0_, t1_, s_) do { const int bse_ = 8 * ((s_) & 1); v4u w_; \
        if ((s_) < 2) { w_.x = cvt2(t0_[bse_ + 0], t0_[bse_ + 1]); w_.y = cvt2(t0_[bse_ + 2], t0_[bse_ + 3]); w_.z = cvt2(t0_[bse_ + 4], t0_[bse_ + 5]); w_.w = cvt2(t0_[bse_ + 6], t0_[bse_ + 7]); } \
        else { w_.x = cvt2(t1_[bse_ + 0], t1_[bse_ + 1]); w_.y = cvt2(t1_[bse_ + 2], t1_[bse_ + 3]); w_.z = cvt2(t1_[bse_ + 4], t1_[bse_ + 5]); w_.w = cvt2(t1_[bse_ + 6], t1_[bse_ + 7]); } \
        dst = __builtin_bit_cast(bf16x8, w_); } while (0)
#define LDF(off_) (*(const LAS bf16x8*)(buf + (off_)))
        if (bx < 32) {
            const int bh = bx, b = bh >> 3, h = bh & 7; const size_t rowbase = (size_t)b * SEQ;
            constexpr int OK_ = 0, OQ_ = 64 * RS, OKT_ = 2 * 64 * RS, OTM_ = OKT_ + 128 * RH, OAT_ = OTM_ + 64 * RH;
            static_assert(OAT_ + 64 * RH == SBUF, "GDN chunk buffer");
            f32x16 S[4];
#pragma unroll
            for (int dt = 0; dt < 4; ++dt) S[dt] = Z16;
            f32x16 L0, L1, L2, L3; float lg = 0.f, lgl = 0.f, lb_ = 0.f;
            f32x16 P0, P1;
            const int n0 = 32 * (wave & 3); const int voff = (4 * (lane >> 5) * GW + (lane & 31)) * 4;
            const int fa = (lane & 31) * RS + (lane >> 5) * 16, fh = (lane & 31) * RH + (lane >> 5) * 16;
#define G_LOAD(cn_) do { int lt_ = tid - 256; asm volatile("" : "+v"(lt_)); const int task_ = ((b * 64 + (cn_)) << 3) + h; \
            _Pragma("unroll") for (int p = 0; p < 4; ++p) { const int idx = lt_ + 256 * p; const size_t o_ = (rowbase + (cn_) * 64 + (idx >> 4)) * GW + h * HD + 8 * (idx & 15); \
                { const v4u v_ = *(const v4u*)(KR + o_); L0[4 * p + 0] = __uint_as_float(v_.x); L0[4 * p + 1] = __uint_as_float(v_.y); L0[4 * p + 2] = __uint_as_float(v_.z); L0[4 * p + 3] = __uint_as_float(v_.w); } { const v4u v_ = *(const v4u*)(QR + o_); L1[4 * p + 0] = __uint_as_float(v_.x); L1[4 * p + 1] = __uint_as_float(v_.y); L1[4 * p + 2] = __uint_as_float(v_.z); L1[4 * p + 3] = __uint_as_float(v_.w); } { const v4u v_ = *(const v4u*)(KT + (size_t)(bh * HD + (idx >> 3)) * SEQ + (cn_) * 64 + 8 * (idx & 7)); L2[4 * p + 0] = __uint_as_float(v_.x); L2[4 * p + 1] = __uint_as_float(v_.y); L2[4 * p + 2] = __uint_as_float(v_.z); L2[4 * p + 3] = __uint_as_float(v_.w); } } \
            _Pragma("unroll") for (int p = 0; p < 2; ++p) { const int idx = lt_ + 256 * p; const size_t o_ = (size_t)task_ * 4096 + (idx >> 3) * 64 + 8 * (idx & 7); { const v4u v_ = *(const v4u*)(TM + o_); L3[4 * p + 0] = __uint_as_float(v_.x); L3[4 * p + 1] = __uint_as_float(v_.y); L3[4 * p + 2] = __uint_as_float(v_.z); L3[4 * p + 3] = __uint_as_float(v_.w); } { const v4u v_ = *(const v4u*)(ATT + o_); L3[8 + 4 * p + 0] = __uint_as_float(v_.x); L3[8 + 4 * p + 1] = __uint_as_float(v_.y); L3[8 + 4 * p + 2] = __uint_as_float(v_.z); L3[8 + 4 * p + 3] = __uint_as_float(v_.w); } } \
            if (lt_ < 64) { lg = GG[(rowbase + (cn_) * 64 + lt_) * 8 + h]; lgl = GG[(rowbase + (cn_) * 64 + 63) * 8 + h]; lb_ = BETA[(rowbase + (cn_) * 64 + lt_) * 8 + h]; } } while (0)
#define G_WRITE(cn_) do { int lt_ = tid - 256; asm volatile("" : "+v"(lt_)); LAS unsigned char* buf_ = lds + ((cn_) & 1) * SBUF; \
            _Pragma("unroll") for (int p = 0; p < 4; ++p) { const int idx = lt_ + 256 * p; { const int o_ = (idx >> 4) * RS + (idx & 15) * 16; *(LAS v4u*)(buf_ + OK_ + o_) = (v4u){__float_as_uint(L0[4 * p + 0]), __float_as_uint(L0[4 * p + 1]), __float_as_uint(L0[4 * p + 2]), __float_as_uint(L0[4 * p + 3])}; *(LAS v4u*)(buf_ + OQ_ + o_) = (v4u){__float_as_uint(L1[4 * p + 0]), __float_as_uint(L1[4 * p + 1]), __float_as_uint(L1[4 * p + 2]), __float_as_uint(L1[4 * p + 3])}; } \
                *(LAS v4u*)(buf_ + OKT_ + (idx >> 3) * RH + (idx & 7) * 16) = (v4u){__float_as_uint(L2[4 * p + 0]), __float_as_uint(L2[4 * p + 1]), __float_as_uint(L2[4 * p + 2]), __float_as_uint(L2[4 * p + 3])}; } \
            _Pragma("unroll") for (int p = 0; p < 2; ++p) { const int idx = lt_ + 256 * p; const int o_ = (idx >> 3) * RH + (idx & 7) * 16; *(LAS v4u*)(buf_ + OTM_ + o_) = (v4u){__float_as_uint(L3[4 * p + 0]), __float_as_uint(L3[4 * p + 1]), __float_as_uint(L3[4 * p + 2]), __float_as_uint(L3[4 * p + 3])}; *(LAS v4u*)(buf_ + OAT_ + o_) = (v4u){__float_as_uint(L3[8 + 4 * p + 0]), __float_as_uint(L3[8 + 4 * p + 1]), __float_as_uint(L3[8 + 4 * p + 2]), __float_as_uint(L3[8 + 4 * p + 3])}; } \
            if (lt_ < 64) { LAS float* tb_ = (LAS float*)(lds + TAB_OFF + ((cn_) & 1) * 1024); tb_[lt_] = lb_; tb_[64 + lt_] = __expf(lg); tb_[128 + lt_] = __expf(lgl - lg); } } while (0)
#define V_LOAD(cn_) do { const __amdgpu_buffer_rsrc_t vr_ = __builtin_amdgcn_make_buffer_rsrc(VF + (rowbase + (size_t)(cn_) * 64) * GW + h * HD + n0, 0, 64 * GW * 4, 0x00020000); \
            _Pragma("unroll") for (int e = 0; e < 16; ++e) { const int so = ((e & 3) + 8 * (e >> 2)) * GW * 4; \
                P0[e] = __uint_as_float(__builtin_amdgcn_raw_buffer_load_b32(vr_, voff, so, 0)); P1[e] = __uint_as_float(__builtin_amdgcn_raw_buffer_load_b32(vr_, voff, so + 32 * GW * 4, 0)); } } while (0)
            if (wave >= 4) {
                G_LOAD(0);
                for (int c = -1; c < SEQ / 64; ++c) {
                    if (c + 1 < SEQ / 64) { G_WRITE(c + 1); if (c + 2 < SEQ / 64) G_LOAD(c + 2); }
                    asm volatile("s_waitcnt lgkmcnt(0)" ::: "memory"); __builtin_amdgcn_s_barrier(); asm volatile("" ::: "memory");
                }
            } else {
                V_LOAD(0);
                asm volatile("s_waitcnt lgkmcnt(0)" ::: "memory"); __builtin_amdgcn_s_barrier(); asm volatile("" ::: "memory");
                for (int c = 0; c < SEQ / 64; ++c) {
                    const LAS unsigned char* buf = lds + (c & 1) * SBUF; const LAS float* tb = (const LAS float*)(lds + TAB_OFF + (c & 1) * 1024); const int hl = lane >> 5;
                    f32x16 p0, p1, o0, o1;
                    bf16x8 rf[4];
#pragma unroll
                    for (int a = 0; a < 4; ++a) { const int t4 = 8 * a + 4 * hl; const f32x4 b0 = *(const LAS f32x4*)(tb + t4), b1 = *(const LAS f32x4*)(tb + 32 + t4);
#pragma unroll
                        for (int e = 0; e < 4; ++e) { P0[4 * a + e] *= b0[e]; P1[4 * a + e] *= b1[e]; } }
#pragma unroll
                    for (int s = 0; s < 4; ++s) TFRAG(rf[s], P0, P1, s);
#pragma unroll
                    for (int s = 0; s < 4; ++s) { const bf16x8 t0 = LDF(OTM_ + fh + 32 * s), t1 = LDF(OTM_ + 32 * RH + fh + 32 * s); p0 = MFMA32(t0, rf[s], s == 0 ? Z16 : p0); p1 = MFMA32(t1, rf[s], s == 0 ? Z16 : p1); }
                    { const int cv = (c + 1 < SEQ / 64) ? c + 1 : c; V_LOAD(cv); }
                    bf16x8 sf[8];
#pragma unroll
                    for (int s = 0; s < 8; ++s) {
                        SFRAG(sf[s], s);
                        const bf16x8 k0 = LDF(OK_ + fa + 32 * s), k1 = LDF(OK_ + 32 * RS + fa + 32 * s);
                        p0 = MFMA32(k0, sf[s], p0); p1 = MFMA32(k1, sf[s], p1);
                    }
                    bf16x8 uf[4];
#pragma unroll
                    for (int s = 0; s < 4; ++s) TFRAG(uf[s], p0, p1, s);
#pragma unroll
                    for (int a = 0; a < 4; ++a) { const int t4 = 8 * a + 4 * hl; const f32x4 d0 = *(const LAS f32x4*)(tb + 128 + t4), d1 = *(const LAS f32x4*)(tb + 160 + t4);
#pragma unroll
                        for (int e = 0; e < 4; ++e) { p0[4 * a + e] *= d0[e]; p1[4 * a + e] *= d1[e]; } }
#pragma unroll
                    for (int s = 0; s < 4; ++s) TFRAG(rf[s], p0, p1, s);
                    const float sd = tb[64 + 63];
#pragma unroll
                    for (int dt = 0; dt < 4; ++dt) {
#pragma unroll
                        for (int e = 0; e < 16; ++e) S[dt][e] *= sd;
#pragma unroll
                        for (int s = 0; s < 4; ++s) S[dt] = MFMA32(LDF(OKT_ + 32 * dt * RH + fh + 32 * s), rf[s], S[dt]);
                    }
#pragma unroll
                    for (int s = 0; s < 4; ++s) { const bf16x8 a0 = LDF(OAT_ + fh + 32 * s), a1 = LDF(OAT_ + 32 * RH + fh + 32 * s); o0 = MFMA32(a0, uf[s], s == 0 ? Z16 : o0); o1 = MFMA32(a1, uf[s], s == 0 ? Z16 : o1); }
#pragma unroll
                    for (int s = 0; s < 8; ++s) {
                        const bf16x8 q0 = LDF(OQ_ + fa + 32 * s), q1 = LDF(OQ_ + 32 * RS + fa + 32 * s);
                        p0 = MFMA32(q0, sf[s], s == 0 ? Z16 : p0); p1 = MFMA32(q1, sf[s], s == 0 ? Z16 : p1);
                    }
#pragma unroll
                    for (int a = 0; a < 4; ++a) { const int t4 = 8 * a + 4 * hl; const f32x4 g0 = *(const LAS f32x4*)(tb + 64 + t4), g1 = *(const LAS f32x4*)(tb + 96 + t4);
#pragma unroll
                        for (int e = 0; e < 4; ++e) { o0[4 * a + e] += g0[e] * p0[4 * a + e]; o1[4 * a + e] += g1[e] * p1[4 * a + e]; } }
#pragma unroll
                    for (int hf = 0; hf < 2; ++hf) {
                        LAS unsigned char* ost = lds + OST_OFF + wave * 2048;
#pragma unroll
                        for (int e = 0; e < 16; ++e) *(LAS unsigned short*)(ost + ((e & 3) + 8 * (e >> 2) + 4 * hl) * 64 + 2 * (lane & 31)) = (unsigned short)(cvt2(hf ? o1[e] : o0[e], 0.f) & 0xffffu);
                        LDS_WAIT(); asm volatile("" ::: "memory");
                        const v4u w0 = *(const LAS v4u*)(ost + lane * 32), w1 = *(const LAS v4u*)(ost + lane * 32 + 16);
                        LDS_WAIT(); asm volatile("" ::: "memory");
                        bf16* op = OA + (rowbase + (size_t)c * 64 + 32 * hf + (lane >> 1)) * GW + h * HD + n0 + 16 * (lane & 1);
                        *(v4u*)op = w0; *(v4u*)(op + 8) = w1;
                    }
                    asm volatile("s_waitcnt lgkmcnt(0)" ::: "memory"); __builtin_amdgcn_s_barrier(); asm volatile("" ::: "memory");
                }
            }
#undef G_LOAD
#undef G_WRITE
#undef V_LOAD
        } else if (bx < 64) {
            const int bh = bx - 32, b = bh >> 3, h = bh & 7; const size_t rowbase = (size_t)b * SEQ;
            constexpr int OQ_ = 0, OKT_ = 64 * RS, OVT_ = OKT_ + 128 * RH, OA_ = OVT_ + 128 * RH;
            static_assert(OA_ + 64 * RH <= SBUF, "HGRN2 chunk buffer");
            LAS unsigned char* tab = lds + TAB_OFF;
            f32x16 S[4];
#pragma unroll
            for (int dt = 0; dt < 4; ++dt) S[dt] = Z16;
            f32x16 L0, L1, L2, L3;
            const int fa = (lane & 31) * RS + (lane >> 5) * 16, fh = (lane & 31) * RH + (lane >> 5) * 16;
#define H_LOAD(cn_) do { int lt_ = tid - 256; asm volatile("" : "+v"(lt_)); const int task_ = ((b * 64 + (cn_)) << 3) + h; \
            _Pragma("unroll") for (int p = 0; p < 4; ++p) { const int idx = lt_ + 256 * p; { const v4u v_ = *(const v4u*)(PSLOT(4) + (rowbase + (cn_) * 64 + (idx >> 4)) * GW + h * HD + 8 * (idx & 15)); L0[4 * p + 0] = __uint_as_float(v_.x); L0[4 * p + 1] = __uint_as_float(v_.y); L0[4 * p + 2] = __uint_as_float(v_.z); L0[4 * p + 3] = __uint_as_float(v_.w); } \
                { const v4u v_ = *(const v4u*)(HKT + (size_t)(bh * HD + (idx >> 3)) * SEQ + (cn_) * 64 + 8 * (idx & 7)); L1[4 * p + 0] = __uint_as_float(v_.x); L1[4 * p + 1] = __uint_as_float(v_.y); L1[4 * p + 2] = __uint_as_float(v_.z); L1[4 * p + 3] = __uint_as_float(v_.w); } { const v4u v_ = *(const v4u*)(HVT + (size_t)(bh * HD + (idx >> 3)) * SEQ + (cn_) * 64 + 8 * (idx & 7)); L2[4 * p + 0] = __uint_as_float(v_.x); L2[4 * p + 1] = __uint_as_float(v_.y); L2[4 * p + 2] = __uint_as_float(v_.z); L2[4 * p + 3] = __uint_as_float(v_.w); } } \
            _Pragma("unroll") for (int p = 0; p < 2; ++p) { const int idx = lt_ + 256 * p; { const v4u v_ = *(const v4u*)(HA + (size_t)task_ * 4096 + (idx >> 3) * 64 + 8 * (idx & 7)); L3[4 * p + 0] = __uint_as_float(v_.x); L3[4 * p + 1] = __uint_as_float(v_.y); L3[4 * p + 2] = __uint_as_float(v_.z); L3[4 * p + 3] = __uint_as_float(v_.w); } } \
            { const v4u v_ = *(const v4u*)(DTAB + (size_t)task_ * HD + 4 * (lt_ & 31)); L3[8 + 0] = __uint_as_float(v_.x); L3[8 + 1] = __uint_as_float(v_.y); L3[8 + 2] = __uint_as_float(v_.z); L3[8 + 3] = __uint_as_float(v_.w); } } while (0)
#define H_WRITE(cn_) do { int lt_ = tid - 256; asm volatile("" : "+v"(lt_)); LAS unsigned char* buf_ = lds + ((cn_) & 1) * SBUF; \
            _Pragma("unroll") for (int p = 0; p < 4; ++p) { const int idx = lt_ + 256 * p; *(LAS v4u*)(buf_ + OQ_ + (idx >> 4) * RS + (idx & 15) * 16) = (v4u){__float_as_uint(L0[4 * p + 0]), __float_as_uint(L0[4 * p + 1]), __float_as_uint(L0[4 * p + 2]), __float_as_uint(L0[4 * p + 3])}; \
                { const int o_ = (idx >> 3) * RH + (idx & 7) * 16; *(LAS v4u*)(buf_ + OKT_ + o_) = (v4u){__float_as_uint(L1[4 * p + 0]), __float_as_uint(L1[4 * p + 1]), __float_as_uint(L1[4 * p + 2]), __float_as_uint(L1[4 * p + 3])}; *(LAS v4u*)(buf_ + OVT_ + o_) = (v4u){__float_as_uint(L2[4 * p + 0]), __float_as_uint(L2[4 * p + 1]), __float_as_uint(L2[4 * p + 2]), __float_as_uint(L2[4 * p + 3])}; } } \
            _Pragma("unroll") for (int p = 0; p < 2; ++p) { const int idx = lt_ + 256 * p; *(LAS v4u*)(buf_ + OA_ + (idx >> 3) * RH + (idx & 7) * 16) = (v4u){__float_as_uint(L3[4 * p + 0]), __float_as_uint(L3[4 * p + 1]), __float_as_uint(L3[4 * p + 2]), __float_as_uint(L3[4 * p + 3])}; } \
            if (lt_ < 32) *(LAS v4u*)(tab + ((cn_) & 1) * 512 + 16 * lt_) = (v4u){__float_as_uint(L3[8 + 0]), __float_as_uint(L3[8 + 1]), __float_as_uint(L3[8 + 2]), __float_as_uint(L3[8 + 3])}; } while (0)
            if (wave >= 4) {
                H_LOAD(0);
                for (int c = -1; c < SEQ / 64; ++c) {
                    if (c + 1 < SEQ / 64) { H_WRITE(c + 1); if (c + 2 < SEQ / 64) H_LOAD(c + 2); }
                    asm volatile("s_waitcnt lgkmcnt(0)" ::: "memory"); __builtin_amdgcn_s_barrier(); asm volatile("" ::: "memory");
                }
            } else {
                asm volatile("s_waitcnt lgkmcnt(0)" ::: "memory"); __builtin_amdgcn_s_barrier(); asm volatile("" ::: "memory");
                for (int c = 0; c < SEQ / 64; ++c) {
                    const LAS unsigned char* buf = lds + (c & 1) * SBUF; const int n0 = 32 * wave, hl = lane >> 5;
                    bf16x8 sf[8];
#pragma unroll
                    for (int s = 0; s < 8; ++s) SFRAG(sf[s], s);
                    bf16x8 vf[4];
#pragma unroll
                    for (int s = 0; s < 4; ++s) vf[s] = LDF(OVT_ + n0 * RH + fh + 32 * s);
#pragma unroll
                    for (int dt = 0; dt < 4; ++dt) {
#pragma unroll
                        for (int s = 0; s < 4; ++s) S[dt] = MFMA32(LDF(OKT_ + 32 * dt * RH + fh + 32 * s), vf[s], S[dt]);
#pragma unroll
                        for (int a = 0; a < 4; ++a) { const f32x4 dv = *(const LAS f32x4*)(tab + (c & 1) * 512 + (32 * dt + 8 * a + 4 * hl) * 4);
#pragma unroll
                            for (int e = 0; e < 4; ++e) S[dt][4 * a + e] *= dv[e]; }
                    }
                    f32x16 o0, o1;
#pragma unroll
                    for (int s = 0; s < 8; ++s) { const bf16x8 q0 = LDF(OQ_ + fa + 32 * s), q1 = LDF(OQ_ + 32 * RS + fa + 32 * s); o0 = MFMA32(q0, sf[s], s == 0 ? Z16 : o0); o1 = MFMA32(q1, sf[s], s == 0 ? Z16 : o1); }
#pragma unroll
                    for (int s = 0; s < 4; ++s) { const bf16x8 a0 = LDF(OA_ + fh + 32 * s), a1 = LDF(OA_ + 32 * RH + fh + 32 * s); o0 = MFMA32(a0, vf[s], o0); o1 = MFMA32(a1, vf[s], o1); }
#pragma unroll
                    for (int hf = 0; hf < 2; ++hf) {
                        LAS unsigned char* ost = lds + OST_OFF + wave * 2048;
#pragma unroll
                        for (int e = 0; e < 16; ++e) *(LAS unsigned short*)(ost + ((e & 3) + 8 * (e >> 2) + 4 * hl) * 64 + 2 * (lane & 31)) = (unsigned short)(cvt2(hf ? o1[e] : o0[e], 0.f) & 0xffffu);
                        LDS_WAIT(); asm volatile("" ::: "memory");
                        const v4u w0 = *(const LAS v4u*)(ost + lane * 32), w1 = *(const LAS v4u*)(ost + lane * 32 + 16);
                        LDS_WAIT(); asm volatile("" ::: "memory");
                        bf16* op = OBH + (rowbase + (size_t)c * 64 + 32 * hf + (lane >> 1)) * GW + h * HD + n0 + 16 * (lane & 1);
                        *(v4u*)op = w0; *(v4u*)(op + 8) = w1;
                    }
                    asm volatile("s_waitcnt lgkmcnt(0)" ::: "memory"); __builtin_amdgcn_s_barrier(); asm volatile("" ::: "memory");
                }
            }
#undef H_LOAD
#undef H_WRITE
        }
#undef SFRAG
#undef TFRAG
#undef LDF
    }
    SEAM(PH_SCAN);

    if (IN(PH_GNORM)) {
        f32x2 nwa, nwb; nwa = *(const f32x2*)(gdn_nw + 2 * lane); nwb = *(const f32x2*)(hgrn_nw + 2 * lane);
        for (int m = gw * 8; m < M; m += NGW * 8) {
#pragma unroll 1
            for (int mi = 0; mi < 8; ++mi) {
                const size_t off = (size_t)(m + mi) * GW + 2 * lane;
                f32x2 o[16]; unsigned gu[16];
#pragma unroll
                for (int hs = 0; hs < 16; ++hs) { const int h = hs & 7; const unsigned ou = *(const unsigned*)((hs >= 8 ? OBH : OA) + off + h * HD); o[hs] = (f32x2){bf_lo(ou), bf_hi(ou)}; gu[hs] = *(const unsigned*)((hs >= 8 ? PSLOT(7) : PSLOT(3)) + off + h * HD); }
#pragma unroll
                for (int hs = 0; hs < 16; ++hs) {
                    const float ms = wave_sum(o[hs][0] * o[hs][0] + o[hs][1] * o[hs][1]) * (1.0f / HD); const float r = __builtin_amdgcn_rsqf(ms + NORM_EPS);
                    const f32x2 nw = hs >= 8 ? nwb : nwa;
                    *(unsigned*)(Y + (size_t)(m + mi) * D + hs * HD + 2 * lane) = cvt2(o[hs][0] * r * nw[0] * siluf_(bf_lo(gu[hs])), o[hs][1] * r * nw[1] * siluf_(bf_hi(gu[hs])));
                }
            }
        }
    }
    SEAM(PH_GNORM);

    if (IN(PH_G2)) {
        pg8::Gemm g{Y, WOUT_T, M, D, D}; pg8::StaticOrder S; S.init(M, D, G, bx);
        pg8::EpiResidToBf E{x, HB, SS1, D};
        pg8::gemm_phase<pg8::EpiResidToBf, pg8::StaticOrder, true, true>(lds, g, S, E);
    }
    SEAM(PH_G2);

    if (IN(PH_G3)) {
        pg8::Gemm g{HB, W1_T, M, FF, D}; pg8::StaticOrder S; S.init(M, FF, G, bx);
        pg8::EpiAct E{ACT, FF, SS1, 1.0f / D, NORM_EPS};
        pg8::gemm_phase<pg8::EpiAct, pg8::StaticOrder, true, true>(lds, g, S, E);
    }
    SEAM(PH_G3);

    if (IN(PH_G4)) {
        pg8::Gemm g{ACT, W2_T, M, D, FF}; pg8::StaticOrder S; S.init(M, D, G, bx);
        pg8::EpiResidFromBf E{HB, SS2, D};
        pg8::gemm_phase<pg8::EpiResidFromBf, pg8::StaticOrder, true, true>(lds, g, S, E);
    }
    SEAM(PH_G4);

    if (IN(PH_FIN)) {
        for (int m = gw * 2; m < M; m += NGW * 2) {
            const float pa = (lane < 32) ? SS2[(size_t)m * 32 + lane] : 0.f, pb = (lane < 32) ? SS2[(size_t)(m + 1) * 32 + lane] : 0.f;
            v4u ha[4], hb4[4];
#pragma unroll
            for (int j = 0; j < 4; ++j) { ha[j] = *(const v4u*)(HB + (size_t)m * D + 512 * j + 8 * lane); hb4[j] = *(const v4u*)(HB + (size_t)(m + 1) * D + 512 * j + 8 * lane); }
            const float ra = __builtin_amdgcn_rsqf(wave_sum(pa) * (1.0f / D) + NORM_EPS), rb = __builtin_amdgcn_rsqf(wave_sum(pb) * (1.0f / D) + NORM_EPS);
#pragma unroll
            for (int j = 0; j < 4; ++j) {
                const f32x4 w0 = *(const f32x4*)(w_fin + 512 * j + 8 * lane), w1 = *(const f32x4*)(w_fin + 512 * j + 8 * lane + 4);
                f32x4* oa = (f32x4*)(out + (size_t)m * D + 512 * j + 8 * lane); f32x4* ob = (f32x4*)(out + (size_t)(m + 1) * D + 512 * j + 8 * lane);
                oa[0] = (f32x4){bf_lo(ha[j].x), bf_hi(ha[j].x), bf_lo(ha[j].y), bf_hi(ha[j].y)} * ra * w0; oa[1] = (f32x4){bf_lo(ha[j].z), bf_hi(ha[j].z), bf_lo(ha[j].w), bf_hi(ha[j].w)} * ra * w1;
                ob[0] = (f32x4){bf_lo(hb4[j].x), bf_hi(hb4[j].x), bf_lo(hb4[j].y), bf_hi(hb4[j].y)} * rb * w0; ob[1] = (f32x4){bf_lo(hb4[j].z), bf_hi(hb4[j].z), bf_lo(hb4[j].w), bf_hi(hb4[j].w)} * rb * w1;
            }
        }
    }
#undef IN
#undef SEAM
#undef PSLOT
}

extern "C" void kernel_launch(void* const* d_in, const int* in_sizes, int n_in, void* d_out, int out_size, void* d_ws, size_t ws_size, hipStream_t stream) {
    static int grid = 0;
    if (grid == 0) {
        if (n_in != 14 || in_sizes[0] != M * D || out_size != M * D || ws_size < WS_END) { fprintf(stderr, "kernel_launch: shape/workspace mismatch (n_in %d, in0 %d, out %d, ws %zu)\n", n_in, n_in > 0 ? in_sizes[0] : -1, out_size, ws_size); grid = -1; return; }
        int dev = 0, cus = 0, per_cu = 0;
        if (hipGetDevice(&dev) != hipSuccess || hipDeviceGetAttribute(&cus, hipDeviceAttributeMultiprocessorCount, dev) != hipSuccess) { grid = -1; return; }
        if (hipFuncSetAttribute((const void*)hyb_fwd, hipFuncAttributeMaxDynamicSharedMemorySize, LDS_BYTES) != hipSuccess) { fprintf(stderr, "kernel_launch: hipFuncSetAttribute failed\n"); grid = -1; return; }
        if (hipOccupancyMaxActiveBlocksPerMultiprocessor(&per_cu, (const void*)hyb_fwd, NTHREADS, LDS_BYTES) != hipSuccess || per_cu < 1) { fprintf(stderr, "kernel_launch: occupancy query says %d blocks per CU\n", per_cu); grid = -1; (void)hipGetLastError(); return; }
        grid = cus;
    }
    if (grid < 0) return;
    if (hipMemsetAsync((char*)d_ws + WS_CTL, 0, CTL_ZERO_BYTES, stream) != hipSuccess) return;
    Args a{};
    for (int i = 0; i < 14; ++i) a.in[i] = (const float*)d_in[i];
    a.out = (float*)d_out; a.ws = (unsigned char*)d_ws;
    for (int li = 0; li < N_LAUNCHES; ++li) {
        a.ph_lo = (N_LAUNCHES == 1) ? 0 : li; a.ph_hi = (N_LAUNCHES == 1) ? N_PHASES : li + 1; a.li = li;
        hipLaunchKernelGGL(hyb_fwd, dim3(grid), dim3(NTHREADS), LDS_BYTES, stream, a);
        const hipError_t le = hipPeekAtLastError();
        if (le != hipSuccess) { fprintf(stderr, "kernel_launch: launch %d failed: %s\n", li, hipGetErrorName(le)); break; }
    }
}
```
